# Optimizing an MI355X kernel written in HIP

```python
import jax
import jax.numpy as jnp
from jax import lax
import numpy as np

D_MODEL = 1024
BATCH = 8
SEQ = 4096
DEPTH = 4

GRID_W = 64
CTX_LEN = 256
N_MIXERS = 2
RET_HEADS = 4
RET_QK_DIM = D_MODEL // RET_HEADS
RET_V_DIM = 2 * D_MODEL // RET_HEADS
RET_CHUNK = 128
NAT_HEAD_DIM = 32
NAT_HEADS = D_MODEL // NAT_HEAD_DIM
NAT_WIN_ROWS = 8
NAT_WIN_COLS = 16
MLP_HIDDEN = 4 * D_MODEL
ROPE_BASE = 10000.0
LN_EPS = 1e-5
DN_ALPHA = (2.0 * DEPTH) ** 0.25
DN_BETA = (8.0 * DEPTH) ** -0.25
N_RET_LAYERS = (DEPTH + 1) // 2
N_NAT_LAYERS = DEPTH // 2

kernel_name = 'hybrid_retention_natten_dit'


def layer_norm(x, g, b):
    xf = x.astype(jnp.float32)
    mu = jnp.mean(xf, axis=-1, keepdims=True)
    var = jnp.mean(jnp.square(xf - mu), axis=-1, keepdims=True)
    return ((xf - mu) * lax.rsqrt(var + LN_EPS) * g + b).astype(x.dtype)


def axial_rope_angles(n, axis_dim):
    t = jnp.arange(n)
    row = (t // GRID_W).astype(jnp.float32)
    col = (t % GRID_W).astype(jnp.float32)
    inv = 1.0 / (ROPE_BASE ** (jnp.arange(0, axis_dim, 2, dtype=jnp.float32) / axis_dim))
    return row[:, None] * inv, col[:, None] * inv


def rope_rotate(x, ang):
    cos = jnp.cos(ang).astype(x.dtype)
    sin = jnp.sin(ang).astype(x.dtype)
    x1, x2 = jnp.split(x, 2, axis=-1)
    return jnp.concatenate([x1 * cos - x2 * sin, x2 * cos + x1 * sin], axis=-1)


def axial_rope(x, ang_row, ang_col):
    xr, xc = jnp.split(x, 2, axis=-1)
    return jnp.concatenate([rope_rotate(xr, ang_row), rope_rotate(xc, ang_col)], axis=-1)


def retention_chunk_scan(q, k, v, log_gamma, state0, with_out):
    b, h, n, dk = q.shape
    dv = v.shape[-1]
    cs = RET_CHUNK
    nc = n // cs
    dt = v.dtype
    pos = jnp.arange(cs, dtype=jnp.float32)
    lg = log_gamma.astype(jnp.float32)[:, None]
    rel = pos[:, None] - pos[None, :]
    intra = jnp.where(rel >= 0, jnp.exp(lg[:, :, None] * jnp.maximum(rel, 0.0)), 0.0).astype(dt)
    q_dec = jnp.exp(lg * (pos + 1.0))[..., None].astype(dt)
    k_dec = jnp.exp(lg * (cs - 1.0 - pos))[..., None].astype(dt)
    chunk_dec = jnp.exp(lg * cs)[..., None].astype(dt)

    def to_chunks(t):
        return jnp.moveaxis(t.reshape(b, h, nc, cs, t.shape[-1]), 2, 0)

    def step(state, qkv):
        qc, kc, vc = qkv
        new_state = state * chunk_dec + jnp.einsum('bhsd,bhse->bhde', kc * k_dec, vc)
        if with_out:
            scores = jnp.einsum('bhcd,bhsd->bhcs', qc, kc) * intra
            out = (jnp.einsum('bhcs,bhse->bhce', scores, vc)
                   + jnp.einsum('bhcd,bhde->bhce', qc * q_dec, state))
            return new_state, out
        return new_state, None

    state, outs = lax.scan(step, state0, (to_chunks(q), to_chunks(k), to_chunks(v)))
    if with_out:
        outs = jnp.moveaxis(outs, 0, 2).reshape(b, h, n, dv)
    return state, outs


def retention_mixer(h_lat, h_ctx, w_in, w_o, decay_param, ang_row, ang_col, ctx_out):
    b = h_lat.shape[0]
    qk_w = RET_HEADS * RET_QK_DIM
    v_w = RET_HEADS * RET_V_DIM

    def heads(t, hd):
        return t.reshape(b, t.shape[1], RET_HEADS, hd).transpose(0, 2, 1, 3)

    def project(h, w):
        p = h @ w
        q = heads(p[..., :qk_w], RET_QK_DIM)
        k = heads(p[..., qk_w:2 * qk_w], RET_QK_DIM) * (RET_QK_DIM ** -0.5)
        v = heads(p[..., 2 * qk_w:2 * qk_w + v_w], RET_V_DIM)
        return q, k, v, p[..., 2 * qk_w + v_w:]

    def flip(t):
        return t[:, :, ::-1]

    def finish(o, g):
        of = o.astype(jnp.float32)
        mu = jnp.mean(of, axis=-1, keepdims=True)
        var = jnp.mean(jnp.square(of - mu), axis=-1, keepdims=True)
        on = ((of - mu) * lax.rsqrt(var + LN_EPS)).astype(o.dtype)
        on = on.transpose(0, 2, 1, 3).reshape(b, o.shape[2], v_w)
        return (on * jax.nn.silu(g)) @ w_o

    log_gamma = -jnp.exp(decay_param.astype(jnp.float32))
    w_ctx = w_in if ctx_out else w_in[:, :2 * qk_w + v_w]
    q_c, k_c, v_c, g_c = project(h_ctx, w_ctx)
    zeros = jnp.zeros((b, RET_HEADS, RET_QK_DIM, RET_V_DIM), v_c.dtype)
    s_f, o_cf = retention_chunk_scan(q_c, k_c, v_c, log_gamma[0], zeros, ctx_out)
    s_b, o_cb = retention_chunk_scan(flip(q_c), flip(k_c), flip(v_c), log_gamma[1], zeros, ctx_out)

    q_l, k_l, v_l, g_l = project(h_lat, w_in)
    q_l = axial_rope(q_l, ang_row, ang_col)
    k_l = axial_rope(k_l, ang_row, ang_col)
    _, o_lf = retention_chunk_scan(q_l, k_l, v_l, log_gamma[0], s_f, True)
    _, o_lb = retention_chunk_scan(flip(q_l), flip(k_l), flip(v_l), log_gamma[1], s_b, True)
    y_lat = finish(o_lf + flip(o_lb), g_l)
    y_ctx = finish(o_cf + flip(o_cb), g_c) if ctx_out else None
    return y_lat, y_ctx


def neighbourhood_mixer(h_lat, h_ctx, w_in, w_o, rpb, ctx_out):
    b, n, d = h_lat.shape
    rows = n // GRID_W
    kh = min(NAT_WIN_ROWS, rows)
    kw = NAT_WIN_COLS
    nh, hd = NAT_HEADS, NAT_HEAD_DIM
    scale = hd ** -0.5

    p = h_lat @ w_in
    q = p[..., :d].reshape(b, rows, GRID_W, nh, hd) * scale
    k = p[..., d:2 * d].reshape(b, rows, GRID_W, nh, hd)
    v = p[..., 2 * d:].reshape(b, rows, GRID_W, nh, hd)

    pc = h_ctx @ (w_in if ctx_out else w_in[:, d:])
    pc = pc[..., d:] if ctx_out else pc
    L = h_ctx.shape[1]
    k_c = pc[..., :d].reshape(b, L, nh, hd)
    v_c = pc[..., d:].reshape(b, L, nh, hd)

    row_start = jnp.clip(jnp.arange(rows) - kh // 2, 0, rows - kh)
    cols = jnp.arange(GRID_W)
    col_start = jnp.clip(cols - kw // 2, 0, GRID_W - kw)
    col_in = (cols[None, :] >= col_start[:, None]) & (cols[None, :] < col_start[:, None] + kw)
    dc_idx = jnp.clip(cols[None, :] - cols[:, None] + NAT_WIN_COLS - 1, 0, 2 * NAT_WIN_COLS - 2)
    rpb_f = rpb.astype(jnp.float32)
    band = kh * GRID_W

    def row_block(args):
        q_r, r = args
        start = row_start[r]
        k_band = lax.dynamic_slice_in_dim(k, start, kh, axis=1)
        v_band = lax.dynamic_slice_in_dim(v, start, kh, axis=1)
        dr_idx = start + jnp.arange(kh) - r + NAT_WIN_ROWS - 1
        bias = rpb_f[:, dr_idx[None, :, None], dc_idx[:, None, :]]
        bias = jnp.where(col_in[:, None, :], bias, -jnp.inf)
        s_loc = jnp.einsum('bqhd,bikhd->bhqik', q_r, k_band).astype(jnp.float32) + bias
        s_ctx = jnp.einsum('bqhd,blhd->bhql', q_r, k_c).astype(jnp.float32)
        s = jnp.concatenate([s_loc.reshape(b, nh, GRID_W, band), s_ctx], axis=-1)
        prob = jax.nn.softmax(s, axis=-1).astype(v.dtype)
        p_loc = prob[..., :band].reshape(b, nh, GRID_W, kh, GRID_W)
        return (jnp.einsum('bhqik,bikhd->bqhd', p_loc, v_band)
                + jnp.einsum('bhql,blhd->bqhd', prob[..., band:], v_c))

    o = lax.map(row_block, (jnp.moveaxis(q, 1, 0), jnp.arange(rows)))
    y_lat = jnp.moveaxis(o, 0, 1).reshape(b, n, d) @ w_o

    y_ctx = None
    if ctx_out:
        q_c = pc_q = (h_ctx @ w_in[:, :d]).reshape(b, L, nh, hd) * scale
        s = jnp.einsum('blhd,bmhd->bhlm', q_c, k_c).astype(jnp.float32)
        prob = jax.nn.softmax(s, axis=-1).astype(v_c.dtype)
        y_ctx = jnp.einsum('bhlm,bmhd->blhd', prob, v_c).reshape(b, L, d) @ w_o
    return y_lat, y_ctx


def sq_relu_mlp(h, w1, w2):
    return jnp.square(jax.nn.relu(h @ w1)) @ w2


def setup_inputs(seed: int = 0) -> dict:
    key = jax.random.key(seed)
    ks = jax.random.split(key, 17)
    f32 = jnp.float32

    def nrm(k, shape, scale):
        return jax.random.normal(k, shape, f32) * scale

    qk_w = RET_HEADS * RET_QK_DIM
    v_w = RET_HEADS * RET_V_DIM
    base_decay = jnp.log(-jnp.log(1.0 - 2.0 ** (-5.0 - jnp.arange(RET_HEADS, dtype=f32))))
    return {
        'x': nrm(ks[0], (BATCH, SEQ, D_MODEL), 1.0),
        'c': nrm(ks[1], (BATCH, D_MODEL), 1.0),
        'ctx': nrm(ks[2], (BATCH, CTX_LEN, D_MODEL), 1.0),
        'c_ctx': nrm(ks[3], (D_MODEL,), 1.0),
        'ada_w': nrm(ks[4], (DEPTH, D_MODEL, 6 * D_MODEL), 0.5 * D_MODEL ** -0.5),
        'ada_b': nrm(ks[5], (DEPTH, 6 * D_MODEL), 0.02),
        'ret_w_in': nrm(ks[6], (N_RET_LAYERS, D_MODEL, 2 * qk_w + 2 * v_w), D_MODEL ** -0.5),
        'ret_w_o': nrm(ks[7], (N_RET_LAYERS, v_w, D_MODEL), DN_BETA * v_w ** -0.5),
        'ret_decay': base_decay + nrm(ks[8], (N_RET_LAYERS, 2, RET_HEADS), 0.1),
        'nat_w_in': nrm(ks[9], (N_NAT_LAYERS, D_MODEL, 3 * D_MODEL), D_MODEL ** -0.5),
        'nat_w_o': nrm(ks[10], (N_NAT_LAYERS, D_MODEL, D_MODEL), DN_BETA * D_MODEL ** -0.5),
        'nat_rpb': nrm(ks[11], (N_NAT_LAYERS, NAT_HEADS, 2 * NAT_WIN_ROWS - 1, 2 * NAT_WIN_COLS - 1), 0.1),
        'mlp_w1': nrm(ks[12], (DEPTH, D_MODEL, MLP_HIDDEN), D_MODEL ** -0.5),
        'mlp_w2': nrm(ks[13], (DEPTH, MLP_HIDDEN, D_MODEL), DN_BETA * MLP_HIDDEN ** -0.5),
        'ln_g': 1.0 + nrm(ks[14], (DEPTH, 2, D_MODEL), 0.02),
        'ln_b': nrm(ks[15], (DEPTH, 2, D_MODEL), 0.02),
    }


def reference(x, c, ctx, c_ctx, ada_w, ada_b, ret_w_in, ret_w_o, ret_decay,
              nat_w_in, nat_w_o, nat_rpb, mlp_w1, mlp_w2, ln_g, ln_b):
    n = x.shape[1]
    ang_row, ang_col = axial_rope_angles(n, RET_QK_DIM // 2)
    silu_c = jax.nn.silu(c)
    silu_cc = jax.nn.silu(c_ctx)
    for i in range(DEPTH):
        last = i == DEPTH - 1
        j = i // N_MIXERS
        mod = (silu_c @ ada_w[i] + ada_b[i])[:, None, :]
        mod_c = silu_cc @ ada_w[i] + ada_b[i]
        sh1, sc1, g1, sh2, sc2, g2 = jnp.split(mod, 6, axis=-1)
        sh1c, sc1c, g1c, sh2c, sc2c, g2c = jnp.split(mod_c, 6, axis=-1)

        h = x * (1.0 + sc1) + sh1
        hc = ctx * (1.0 + sc1c) + sh1c
        if i % N_MIXERS == 0:
            y, yc = retention_mixer(h, hc, ret_w_in[j], ret_w_o[j], ret_decay[j],
                                    ang_row, ang_col, not last)
        else:
            y, yc = neighbourhood_mixer(h, hc, nat_w_in[j], nat_w_o[j], nat_rpb[j], not last)

        x = layer_norm(DN_ALPHA * x + g1 * y, ln_g[i, 0], ln_b[i, 0])
        h = x * (1.0 + sc2) + sh2
        x = layer_norm(DN_ALPHA * x + g2 * sq_relu_mlp(h, mlp_w1[i], mlp_w2[i]), ln_g[i, 1], ln_b[i, 1])

        if not last:
            ctx = layer_norm(DN_ALPHA * ctx + g1c * yc, ln_g[i, 0], ln_b[i, 0])
            hc = ctx * (1.0 + sc2c) + sh2c
            ctx = layer_norm(DN_ALPHA * ctx + g2c * sq_relu_mlp(hc, mlp_w1[i], mlp_w2[i]),
                             ln_g[i, 1], ln_b[i, 1])
    return x
```

```cpp
#include <hip/hip_runtime.h>
#include <hip/hip_cooperative_groups.h>
#include <cstdio>
namespace cg = cooperative_groups;

#define DI __device__ __forceinline__
#ifndef DUP_G
#define DUP_G 0
#endif
#ifndef DUP_M
#define DUP_M 0
#endif
typedef unsigned short u16;
typedef short bf16x8 __attribute__((ext_vector_type(8)));
typedef short s16x4 __attribute__((ext_vector_type(4)));
typedef float f32x4 __attribute__((ext_vector_type(4)));
typedef __attribute__((address_space(3))) s16x4* lds_s16x4_ptr;

constexpr int M_LAT = 32768, M_ALL = 34816, DM = 1024, TBN = 4352;
constexpr float DN_ALPHA = 1.681792830507429f;
constexpr size_t MiB = 1048576;
constexpr size_t WS_WA = 0, WS_WAO = 12582912, WS_MOD = 16 * MiB, WS_ROPE = 16 * MiB + 917504, WS_XCTX = 17 * MiB,
                 WS_HM = 25 * MiB, WS_P = 93 * MiB, WS_O = 365 * MiB, WS_END = 501 * MiB;
constexpr int LDS_BYTES = 131072;
constexpr int NTHR = 512, NWV = 8;

struct Params {
  const float *x, *c, *ctx, *c_ctx, *ada_w, *ada_b, *ret_w_in, *ret_w_o, *ret_decay, *nat_w_in, *nat_w_o, *nat_rpb, *mlp_w1, *mlp_w2, *ln_g, *ln_b;
  float* out; char* ws;
};

DI u16 f2bf(float f) { return __builtin_bit_cast(u16, (__bf16)f); }
DI float bf2f(u16 h) { return __uint_as_float(((unsigned)h) << 16); }
typedef float f32x2 __attribute__((ext_vector_type(2)));
typedef __bf16 bf16x2_t __attribute__((ext_vector_type(2)));
DI unsigned pk2(float a, float b) { f32x2 v = {a, b}; return __builtin_bit_cast(unsigned, __builtin_convertvector(v, bf16x2_t)); }
DI float siluf(float v) { return v / (1.f + __expf(-v)); }
DI f32x4 mfma16(bf16x8 a, bf16x8 b, f32x4 c) { return __builtin_amdgcn_mfma_f32_16x16x32_bf16(a, b, c, 0, 0, 0); }
DI s16x4 tr_read(const char* p) { return __builtin_bit_cast(s16x4, __builtin_amdgcn_ds_read_tr16_b64_v4i16((lds_s16x4_ptr)p)); }
DI bf16x8 cat8(s16x4 a, s16x4 b) { bf16x8 r; r[0]=a[0]; r[1]=a[1]; r[2]=a[2]; r[3]=a[3]; r[4]=b[0]; r[5]=b[1]; r[6]=b[2]; r[7]=b[3]; return r; }
DI bf16x8 pack8(const float* s) {
  uint4 u; u.x = pk2(s[0], s[1]); u.y = pk2(s[2], s[3]); u.z = pk2(s[4], s[5]); u.w = pk2(s[6], s[7]);
  return __builtin_bit_cast(bf16x8, u);
}
DI float* xrow(const Params& p, int m) { return m < M_LAT ? p.out + (size_t)m * DM : (float*)(p.ws + WS_XCTX) + (size_t)(m - M_LAT) * DM; }
DI int opaque_tid() { int t = threadIdx.x; asm volatile("" : "+v"(t)); return t; }
DI int grp_of(int m) { return m < M_LAT ? (m >> 12) : 8; }

DI void conv_tile(const float* __restrict__ W, int K, int N, u16* __restrict__ Wt, bool permq, int tile, char* lds) {
  const int ntn = N >> 6; const int kt = tile / ntn, nt = tile - kt * ntn;
  const int tid = opaque_tid() & 255;
  u16* T = (u16*)lds + (opaque_tid() >> 8) * 4352;
  __syncthreads();
  {
    const int c4 = (tid & 15) * 4, r0 = tid >> 4;
#pragma unroll
    for (int j = 0; j < 4; ++j) {
      const int kr = r0 + 16 * j;
      const float4 v = *(const float4*)(W + (size_t)(kt * 64 + kr) * N + nt * 64 + c4);
      T[(c4 + 0) * 66 + kr] = f2bf(v.x); T[(c4 + 1) * 66 + kr] = f2bf(v.y); T[(c4 + 2) * 66 + kr] = f2bf(v.z); T[(c4 + 3) * 66 + kr] = f2bf(v.w);
    }
  }
  __syncthreads();
  {
    const int k8 = (tid & 7) * 8;
#pragma unroll
    for (int j = 0; j < 2; ++j) {
      const int nl = (tid >> 3) + 32 * j; int n = nt * 64 + nl;
      if (permq && n < 2048) { const int i = n & 127; n = (n & ~127) + 2 * (i & 63) + (i >> 6); }
      const unsigned* src = (const unsigned*)(T + nl * 66 + k8);
      uint4 u; u.x = src[0]; u.y = src[1]; u.z = src[2]; u.w = src[3];
      *(uint4*)(Wt + (size_t)n * K + kt * 64 + k8) = u;
    }
  }
}
DI void conv_weights(const float* W, int K, int N, u16* Wt, bool permq, char* lds, int bid, int nblk) {
  const int nt = (K >> 6) * (N >> 6);
  for (int t = bid * 2 + (opaque_tid() >> 8); t < nt; t += nblk * 2) conv_tile(W, K, N, Wt, permq, t, lds);
}
DI void conv_WA(const Params& p, int layer, char* lds, int bid, int nblk) {
  const int j = layer >> 1;
  u16* wa = (u16*)(p.ws + WS_WA); u16* wo = (u16*)(p.ws + WS_WAO);
  if ((layer & 1) == 0) {
    conv_weights(p.ret_w_in + (size_t)j * 1024 * 6144, 1024, 6144, wa, true, lds, bid, nblk);
    conv_weights(p.ret_w_o + (size_t)j * 2048 * 1024, 2048, 1024, wo, false, lds, bid, nblk);
  } else {
    conv_weights(p.nat_w_in + (size_t)j * 1024 * 3072, 1024, 3072, wa, false, lds, bid, nblk);
    conv_weights(p.nat_w_o + (size_t)j * 1024 * 1024, 1024, 1024, wo, false, lds, bid, nblk);
  }
}
DI void conv_WB(const Params& p, int layer, char* lds, int bid, int nblk) {
  u16* w1 = (u16*)(p.ws + WS_O); u16* w2 = w1 + (size_t)4096 * 1024;
  conv_weights(p.mlp_w1 + (size_t)layer * 1024 * 4096, 1024, 4096, w1, false, lds, bid, nblk);
  conv_weights(p.mlp_w2 + (size_t)layer * 4096 * 1024, 4096, 1024, w2, false, lds, bid, nblk);
}

DI void mod_phase(const Params& p, char* lds, int bid, int nblk) {
  float* sc = (float*)lds;
  float* red = sc + 9 * 1024;
  float* mod = (float*)(p.ws + WS_MOD);
  const int tid = opaque_tid();
  bool loaded = false;
  for (int item = bid; item < 4 * 192; item += nblk) {
    if (!loaded) {
      for (int i = tid; i < 9 * 1024; i += NTHR) { const float v = i < 8192 ? p.c[i] : p.c_ctx[i - 8192]; sc[i] = siluf(v); }
      loaded = true;
    }
    __syncthreads();
    const int l = item / 192, cgp = item - l * 192;
    const int col = tid & 31, ks = tid >> 5;
    const float* w = p.ada_w + (size_t)l * 1024 * 6144 + cgp * 32 + col;
    float acc[9];
#pragma unroll
    for (int g = 0; g < 9; ++g) acc[g] = 0.f;
#pragma unroll 32
    for (int k = ks * 64; k < ks * 64 + 64; ++k) {
      const float wv = w[(size_t)k * 6144];
#pragma unroll
      for (int g = 0; g < 9; ++g) acc[g] += sc[g * 1024 + k] * wv;
    }
#pragma unroll
    for (int g = 0; g < 9; ++g) red[(ks * 9 + g) * 32 + col] = acc[g];
    __syncthreads();
    for (int idx = tid; idx < 288; idx += NTHR) {
      const int g = idx >> 5, cc = idx & 31;
      float s = 0.f;
#pragma unroll
      for (int k8 = 0; k8 < 16; ++k8) s += red[(k8 * 9 + g) * 32 + cc];
      const int n = cgp * 32 + cc;
      mod[((size_t)l * 9 + g) * 6144 + n] = s + p.ada_b[l * 6144 + n];
    }
  }
  if (bid == nblk - 1) {
    float2* rope = (float2*)(p.ws + WS_ROPE);
    for (int i = tid; i < 4096; i += NTHR) {
      const int pos = i >> 6, pr = i & 63;
      const float inv = 1.0f / powf(10000.0f, (float)(2 * pr) / 128.0f);
      const float ang = (float)pos * inv;
      rope[i] = make_float2(cosf(ang), sinf(ang));
    }
  }
}

DI void ln_phase(const Params& p, bool do_ln, const float* lng, const float* lnb, const float* modn  ,
                 int sh_off, bool write_h, int rows, int bid, int nblk, const float* ypart = nullptr) {
  const int tid_ = opaque_tid(); const int lane = tid_ & 63, w = tid_ >> 6;
  u16* hm = (u16*)(p.ws + WS_HM);
  for (int m = bid * NWV + w; m < rows; m += nblk * NWV) {
    float* xr = xrow(p, m);
    const float* src = do_ln ? xr : (m < M_LAT ? p.x + (size_t)m * DM : p.ctx + (size_t)(m - M_LAT) * DM);
    float4 v[4];
#pragma unroll
    for (int j = 0; j < 4; ++j) v[j] = *(const float4*)(src + j * 256 + lane * 4);
    if (do_ln && m >= M_LAT) {
      const float* yr = ypart + (size_t)(m - M_LAT) * DM;
#pragma unroll
      for (int j = 0; j < 4; ++j) {
        float4 y = *(const float4*)(yr + j * 256 + lane * 4);
#pragma unroll
        for (int kp = 1; kp < 4; ++kp) { const float4 y2 = *(const float4*)(yr + (size_t)kp * 2048 * DM + j * 256 + lane * 4); y.x += y2.x; y.y += y2.y; y.z += y2.z; y.w += y2.w; }
        v[j].x = DN_ALPHA * v[j].x + y.x; v[j].y = DN_ALPHA * v[j].y + y.y; v[j].z = DN_ALPHA * v[j].z + y.z; v[j].w = DN_ALPHA * v[j].w + y.w;
      }
    }
    if (do_ln) {
      float s = 0.f;
#pragma unroll
      for (int j = 0; j < 4; ++j) s += v[j].x + v[j].y + v[j].z + v[j].w;
#pragma unroll
      for (int o = 32; o >= 1; o >>= 1) s += __shfl_xor(s, o);
      const float mu = s * (1.f / 1024.f);
      float q = 0.f;
#pragma unroll
      for (int j = 0; j < 4; ++j) { v[j].x -= mu; v[j].y -= mu; v[j].z -= mu; v[j].w -= mu; q += v[j].x * v[j].x + v[j].y * v[j].y + v[j].z * v[j].z + v[j].w * v[j].w; }
#pragma unroll
      for (int o = 32; o >= 1; o >>= 1) q += __shfl_xor(q, o);
      const float rstd = rsqrtf(q * (1.f / 1024.f) + 1e-5f);
#pragma unroll
      for (int j = 0; j < 4; ++j) {
        const float4 gg = *(const float4*)(lng + j * 256 + lane * 4), bb = *(const float4*)(lnb + j * 256 + lane * 4);
        v[j].x = v[j].x * rstd * gg.x + bb.x; v[j].y = v[j].y * rstd * gg.y + bb.y; v[j].z = v[j].z * rstd * gg.z + bb.z; v[j].w = v[j].w * rstd * gg.w + bb.w;
      }
    }
#pragma unroll
    for (int j = 0; j < 4; ++j) *(float4*)(xr + j * 256 + lane * 4) = v[j];
    if (write_h) {
      const float* mr = modn + (size_t)grp_of(m) * 6144 + sh_off;
#pragma unroll
      for (int j = 0; j < 4; ++j) {
        const float4 sh = *(const float4*)(mr + j * 256 + lane * 4), sc = *(const float4*)(mr + 1024 + j * 256 + lane * 4);
        uint2 u; u.x = pk2(v[j].x * (1.f + sc.x) + sh.x, v[j].y * (1.f + sc.y) + sh.y); u.y = pk2(v[j].z * (1.f + sc.z) + sh.z, v[j].w * (1.f + sc.w) + sh.w);
        *(uint2*)(hm + (size_t)m * DM + j * 256 + lane * 4) = u;
      }
    }
  }
}

enum { EP_RET_QKV = 0, EP_RET_G = 1, EP_NAT = 2, EP_RESID = 3, EP_RELU2 = 4, EP_RESID_SK = 5 };
struct GArgs {
  const u16* A; int lda; const u16* Bt; int ldb; int M, N, K; int m0;
  u16* out; int ldo; const float* gate;
};

DI int lds_byte2(int r, int c) { const int st = (r >> 4) * 2 + (c >> 5), ob = (r & 15) * 64 + (c & 31) * 2; return st * 1024 + (ob ^ (((ob >> 9) & 1) << 5)); }
DI void stage_rc2(int b, int& R, int& C) { const int st = b >> 10, sb = b & 1023, swz = sb ^ (((sb >> 9) & 1) << 5); R = (st >> 1) * 16 + swz / 64; C = (st & 1) * 32 + (swz % 64) / 2; }

template <int MODE, int NJ, bool DRY = false>
DI void gemm_phase(const Params& p, const GArgs& ga, char* lds, int bid, int nblk) {
  constexpr int SROWS = 64 * NJ, GLS = SROWS / 64;
  const int tid = opaque_tid(), lane = tid & 63, w = tid >> 6, wr = w >> 2, wc = w & 3, l15 = lane & 15, g = lane >> 4;
  const bool any_tr = MODE == EP_NAT;
  const int NTn = (any_tr ? 2048 : ga.N) / 256, MTn = ga.M / SROWS;
  const int n_norm = NTn * MTn;
  const int Rm = 256 / NTn, full_sw = (NTn == 4 || NTn == 8 || NTn == 16) ? (MTn / Rm) * 256 : 0;
  const int NTt = any_tr ? 1024 / SROWS : 1, MTt = ga.M / 256;
  constexpr int KSPLIT = MODE == EP_RESID_SK ? 4 : 1;
  const int ntiles = (n_norm + (any_tr ? NTt * MTt : 0)) * KSPLIT;
  constexpr int LPT = 2 + NJ / 2;
  const int grow = lane >> 2, gcol = (((lane & 3) ^ ((lane >> 5) * 3)) << 3);
  const int frd = l15 * 64 + ((g ^ (((l15 >> 3) & 1) * 3)) << 4);
  const int nk32 = (ga.K / KSPLIT) >> 5;
  for (int tu = bid; tu < ntiles; tu += nblk) {
    const int t = tu / KSPLIT, kpart = tu - t * KSPLIT;
    int f0, s0; const u16 *Fb, *Sb; int ldF, ldS; bool transposed = false;
    if (any_tr && t >= n_norm) {
      const int tt = t - n_norm, mt = tt / NTt, nt = tt - mt * NTt;
      transposed = true; f0 = ga.m0 + mt * 256; s0 = 2048 + nt * SROWS;
      Fb = ga.A + (size_t)f0 * ga.lda; ldF = ga.lda; Sb = ga.Bt + (size_t)s0 * ga.ldb; ldS = ga.ldb;
    } else {
      int mt, nt;
      if (nblk == 256 && t < full_sw) {
        const int r = t >> 8, x = t & 7, j = (t & 255) >> 3;
        if (NTn >= 8) { const int nx = NTn >> 3, cx = x % nx, rx = x / nx; nt = cx * 8 + (j & 7); mt = r * Rm + rx * 4 + (j >> 3); }
        else { nt = j & 3; mt = r * Rm + x * 8 + (j >> 2); }
      } else { mt = t / NTn; nt = t - mt * NTn; }
      f0 = nt * 256; s0 = ga.m0 + mt * SROWS;
      Fb = ga.Bt + (size_t)f0 * ga.ldb; ldF = ga.ldb; Sb = ga.A + (size_t)s0 * ga.lda; ldS = ga.lda;
    }
    const u16* Fg = Fb + (size_t)(16 * w + grow) * ldF + gcol + kpart * (ga.K / KSPLIT);
    const u16* Sg = Sb + (size_t)(16 * w + grow) * ldS + gcol + kpart * (ga.K / KSPLIT);
    size_t f128 = (size_t)128 * ldF, s128 = (size_t)128 * ldS;
    asm volatile("" : "+s"(f128), "+s"(s128));
    f32x4 acc[8][NJ];
#pragma unroll
    for (int i = 0; i < 8; ++i)
#pragma unroll
      for (int j = 0; j < NJ; ++j) acc[i][j] = (f32x4){0.f, 0.f, 0.f, 0.f};
#define GSTAGE(kt_) do { \
      const int kc_ = (kt_) < nk32 ? (kt_) : nk32 - 1; \
      char* sb_ = lds + ((kt_) & 3) * 32768 + w * 1024; const int ko_ = DRY ? 0 : (kc_ << 5); \
      const size_t kf_ = f128 + ko_, ks_ = s128 + ko_; \
      __builtin_amdgcn_global_load_lds((const unsigned*)(Fg + ko_), (unsigned*)(sb_), 16, 0, 0); \
      __builtin_amdgcn_global_load_lds((const unsigned*)(Fg + kf_), (unsigned*)(sb_ + 8192), 16, 0, 0); \
      __builtin_amdgcn_global_load_lds((const unsigned*)(Sg + ko_), (unsigned*)(sb_ + 16384), 16, 0, 0); \
      if (NJ == 4) __builtin_amdgcn_global_load_lds((const unsigned*)(Sg + ks_), (unsigned*)(sb_ + 16384 + 8192), 16, 0, 0); } while (0)
#define LOADB_(dst_, st_) do { const char* b_ = lds + (st_) * 32768 + 16384 + (wc * NJ) * 1024 + frd; \
      _Pragma("unroll") for (int j = 0; j < NJ; ++j) dst_[j] = *(const bf16x8*)(b_ + j * 1024); } while (0)
#define LOADA_(dst_, st_, ih_) do { const char* a_ = lds + (st_) * 32768 + (wr * 8 + (ih_) * 4) * 1024 + frd; \
      _Pragma("unroll") for (int i = 0; i < 4; ++i) dst_[i] = *(const bf16x8*)(a_ + i * 1024); } while (0)
#define MMA_(ih_, fa_, fb_) _Pragma("unroll") for (int i = 0; i < 4; ++i) _Pragma("unroll") for (int j = 0; j < NJ; ++j) acc[(ih_) * 4 + i][j] = mfma16(fa_[i], fb_[j], acc[(ih_) * 4 + i][j])
#define WAIT_LPT() do { if (LPT == 4) asm volatile("s_waitcnt vmcnt(4)" ::: "memory"); else asm volatile("s_waitcnt vmcnt(3)" ::: "memory"); } while (0)
    __builtin_amdgcn_s_barrier();
    GSTAGE(0); GSTAGE(1); GSTAGE(2);
    WAIT_LPT();
    __builtin_amdgcn_s_barrier();
    bf16x8 fbA[NJ], fbB[NJ], fa0[4], fa1[4];
    LOADB_(fbA, 0); LOADA_(fa0, 0, 0);
#pragma unroll 1
    for (int kt = 0; kt < nk32; ++kt) {
      if (kt > 0) { WAIT_LPT(); __builtin_amdgcn_s_barrier(); }
      GSTAGE(kt + 3);
      LOADA_(fa1, kt & 3, 1); MMA_(0, fa0, fbA);
      __builtin_amdgcn_sched_barrier(0);
      LOADB_(fbB, (kt + 1) & 3); LOADA_(fa0, (kt + 1) & 3, 0); MMA_(1, fa1, fbA);
      __builtin_amdgcn_sched_barrier(0);
#pragma unroll
      for (int j = 0; j < NJ; ++j) fbA[j] = fbB[j];
    }
    asm volatile("s_waitcnt vmcnt(0)" ::: "memory");
    int el15 = l15, eg = g, ewr = wr, ewc = wc;
    asm volatile("" : "+v"(el15), "+v"(eg), "+v"(ewr), "+v"(ewc));
    if (DRY) { if (acc[0][0][0] != 1.2345e38f && acc[7][NJ - 1][3] != 3.2145e37f && acc[1][1][1] != 7.7e36f && acc[2][1][2] != 9.9e35f) continue; }
    if (MODE == EP_NAT && transposed) {
      u16* vt = (u16*)(p.ws + WS_P) + (size_t)2 * 35651584;
#pragma unroll
      for (int i = 0; i < 8; ++i) {
        const int m = f0 + ewr * 128 + 16 * i + 4 * eg;
        int b, tq; if (m < M_LAT) { b = m >> 12; tq = m & 4095; } else { b = (m - M_LAT) >> 8; tq = 4096 + ((m - M_LAT) & 255); }
#pragma unroll
        for (int j = 0; j < NJ; ++j) {
          const int n = s0 - 2048 + ewc * (16 * NJ) + 16 * j + el15; const int h = n >> 5, d = n & 31;
          uint2 u; u.x = pk2(acc[i][j][0], acc[i][j][1]); u.y = pk2(acc[i][j][2], acc[i][j][3]);
          *(uint2*)(vt + (((size_t)(b * 32 + h) * (TBN / 4) + (tq >> 2)) * 32 + d) * 4) = u;
        }
      }
    } else if (MODE == EP_RESID) {
      const int nb = f0 + ewr * 128 + 4 * eg;
      const float* gp = ga.gate + (size_t)grp_of(s0) * 6144 + nb;
      float4 gt[8];
#pragma unroll
      for (int i = 0; i < 8; ++i) gt[i] = *(const float4*)(gp + 16 * i);
#pragma unroll
      for (int j = 0; j < NJ; ++j) {
        float* xr = xrow(p, s0 + ewc * (16 * NJ) + 16 * j + el15) + nb;
        float4 xv[8];
#pragma unroll
        for (int i = 0; i < 8; ++i) xv[i] = *(const float4*)(xr + 16 * i);
#pragma unroll
        for (int i = 0; i < 8; ++i) {
          const f32x4 a = acc[i][j];
          float4 o; o.x = DN_ALPHA * xv[i].x + gt[i].x * a[0]; o.y = DN_ALPHA * xv[i].y + gt[i].y * a[1]; o.z = DN_ALPHA * xv[i].z + gt[i].z * a[2]; o.w = DN_ALPHA * xv[i].w + gt[i].w * a[3];
          *(float4*)(xr + 16 * i) = o;
        }
      }
    } else {
#pragma unroll
      for (int j = 0; j < NJ; ++j) {
        const int m = s0 + ewc * (16 * NJ) + 16 * j + el15;
#pragma unroll
        for (int i = 0; i < 8; ++i) {
          const int n = f0 + ewr * 128 + 16 * i + 4 * eg;
          f32x4 a = acc[i][j];
          if (MODE == EP_RELU2) {
            float r0 = fmaxf(a[0], 0.f), r1 = fmaxf(a[1], 0.f), r2 = fmaxf(a[2], 0.f), r3 = fmaxf(a[3], 0.f);
            uint2 u; u.x = pk2(r0 * r0, r1 * r1); u.y = pk2(r2 * r2, r3 * r3);
            *(uint2*)(ga.out + (size_t)m * ga.ldo + n) = u;
          } else if (MODE == EP_RET_G) {
            uint2 u; u.x = pk2(siluf(a[0]), siluf(a[1])); u.y = pk2(siluf(a[2]), siluf(a[3]));
            *(uint2*)(ga.out + (size_t)m * ga.ldo + n) = u;
          } else if (MODE == EP_RESID_SK) {
            float* yr = (float*)ga.out + ((size_t)kpart * 2048 + (m - M_LAT)) * DM + n;
            const float4 gt = *(const float4*)(ga.gate + (size_t)8 * 6144 + n);
            *(float4*)yr = make_float4(gt.x * a[0], gt.y * a[1], gt.z * a[2], gt.w * a[3]);
          } else if (MODE == EP_RESID) {
            float* xr = xrow(p, m) + n;
            const float4 xv = *(const float4*)xr;
            const float4 gt = *(const float4*)(ga.gate + (size_t)grp_of(m) * 6144 + n);
            float4 o; o.x = DN_ALPHA * xv.x + gt.x * a[0]; o.y = DN_ALPHA * xv.y + gt.y * a[1]; o.z = DN_ALPHA * xv.z + gt.z * a[2]; o.w = DN_ALPHA * xv.w + gt.w * a[3];
            *(float4*)xr = o;
          } else if (MODE == EP_RET_QKV) {
            if (n < 2048) {
              if (n >= 1024) { a[0] *= 0.0625f; a[1] *= 0.0625f; a[2] *= 0.0625f; a[3] *= 0.0625f; }
              if (m < M_LAT) {
                const int tk = m & 4095; const int pos = ((n >> 7) & 1) ? (tk & 63) : (tk >> 6);
                const float4 cs = *(const float4*)((const float*)(p.ws + WS_ROPE) + (pos * 64 + ((n & 127) >> 1)) * 2);
                const float x1 = a[0], x2 = a[1], y1 = a[2], y2 = a[3];
                a[0] = x1 * cs.x - x2 * cs.y; a[1] = x2 * cs.x + x1 * cs.y; a[2] = y1 * cs.z - y2 * cs.w; a[3] = y2 * cs.z + y1 * cs.w;
              }
            }
            uint2 u; u.x = pk2(a[0], a[1]); u.y = pk2(a[2], a[3]);
            *(uint2*)(ga.out + (size_t)m * ga.ldo + n) = u;
          } else {
            int b, tq; if (m < M_LAT) { b = m >> 12; tq = m & 4095; } else { b = (m - M_LAT) >> 8; tq = 4096 + ((m - M_LAT) & 255); }
            const int nn = n & 1023; const int h = nn >> 5, d = nn & 31;
            if (n < 1024) { a[0] *= 0.25503472251093067f; a[1] *= 0.25503472251093067f; a[2] *= 0.25503472251093067f; a[3] *= 0.25503472251093067f; }
            u16* dst = (u16*)(p.ws + WS_P) + (n < 1024 ? (size_t)0 : (size_t)35651584) + (((size_t)(b * 32 + h) * 4 + (d >> 3)) * TBN + tq) * 8 + (d & 7);
            uint2 u; u.x = pk2(a[0], a[1]); u.y = pk2(a[2], a[3]);
            *(uint2*)dst = u;
          }
        }
      }
    }
  }
}

DI void half_barrier(unsigned* ctr, unsigned target, int lane) {
  asm volatile("s_waitcnt lgkmcnt(0)" ::: "memory");
  if (lane == 0) (void)__hip_atomic_fetch_add(ctr, 1u, __ATOMIC_RELAXED, __HIP_MEMORY_SCOPE_WORKGROUP);
  while (__hip_atomic_load(ctr, __ATOMIC_RELAXED, __HIP_MEMORY_SCOPE_WORKGROUP) < target) __builtin_amdgcn_s_sleep(1);
  asm volatile("" ::: "memory");
}
DI void scan_phase(const Params& p, int jl, char* lds, int bid, int nblk) {
  const u16* P = (const u16*)(p.ws + WS_P); u16* O = (u16*)(p.ws + WS_O);
  const int tid = opaque_tid(), lane = tid & 63, w = tid >> 6, l15 = lane & 15, g = lane >> 4;
  const int DIR = w >> 2, wq = w & 3, ht = tid & 255;
  char* hb = lds + DIR * 40960;
  char* Qs = hb; char* Ks = hb + 16896; char* Vs = hb + 33792; char* Ps = hb + 38400;
  unsigned* hctr = (unsigned*)(lds + 81920) + DIR * 16;
  unsigned* octr = (unsigned*)(lds + 81920) + (DIR ^ 1) * 16;
  for (int item = bid; item < 256; item += nblk) {
    __syncthreads();
    if (tid < 32) ((unsigned*)(lds + 81920))[tid] = 0u;
    __syncthreads();
    unsigned nbar = 0;
    const int b = item >> 5, h = (item >> 3) & 3, vs = item & 7;
    const float lg2 = -__expf(p.ret_decay[jl * 8 + DIR * 4 + h]) * 1.4426950408889634f;
    const float gC = exp2f(32.f * lg2);
    float qdec[2], kdec[8], dmask[4];
#pragma unroll
    for (int ti = 0; ti < 2; ++ti) { const int tl = 16 * ti + l15; qdec[ti] = exp2f(lg2 * (float)(DIR ? 32 - tl : tl + 1)); }
#pragma unroll
    for (int e = 0; e < 8; ++e) { const int s = 8 * g + e; kdec[e] = exp2f(lg2 * (float)(DIR ? s : 31 - s)); }
    {
      const int t = 16 * (wq & 1) + l15;
#pragma unroll
      for (int r = 0; r < 4; ++r) { const int s = 16 * (wq >> 1) + 4 * g + r; const int d = DIR ? s - t : t - s; dmask[r] = d >= 0 ? exp2f(lg2 * (float)d) : 0.f; }
    }
    f32x4 S[16];
#pragma unroll
    for (int c = 0; c < 16; ++c) S[c] = (f32x4){0.f, 0.f, 0.f, 0.f};
    uint4 rq0, rq1, rq2, rq3, rk0, rk1, rk2, rk3, rv;
    auto row0 = [&](int step) -> int {
      if (step < 8) { const int cc = DIR ? 7 - step : step; return M_LAT + b * 256 + 32 * cc; }
      const int lc = DIR ? 127 - (step - 8) : step - 8; return b * 4096 + 32 * lc;
    };
#define SCAN_GLOAD(m0_) do { \
      const u16* src = P + (size_t)((m0_) + (ht >> 5)) * 4096 + h * 256 + (ht & 31) * 8; \
      rq0 = *(const uint4*)src; rk0 = *(const uint4*)(src + 1024); \
      rq1 = *(const uint4*)(src + 8 * 4096); rk1 = *(const uint4*)(src + 8 * 4096 + 1024); \
      rq2 = *(const uint4*)(src + 16 * 4096); rk2 = *(const uint4*)(src + 16 * 4096 + 1024); \
      rq3 = *(const uint4*)(src + 24 * 4096); rk3 = *(const uint4*)(src + 24 * 4096 + 1024); \
      rv = *(const uint4*)(P + (size_t)((m0_) + (ht >> 3)) * 4096 + 2048 + h * 512 + vs * 64 + (ht & 7) * 8); } while (0)
    SCAN_GLOAD(row0(0));
    for (int step = 0; step < 136; ++step) {
      const int m0 = row0(step);
      asm volatile("s_waitcnt vmcnt(0)" ::: "memory");
      half_barrier(hctr, 4u * (++nbar), lane);
      {
        const int so = (ht >> 5) * 528 + (ht & 31) * 16;
        *(uint4*)(Qs + so) = rq0; *(uint4*)(Ks + so) = rk0; *(uint4*)(Qs + so + 8 * 528) = rq1; *(uint4*)(Ks + so + 8 * 528) = rk1;
        *(uint4*)(Qs + so + 16 * 528) = rq2; *(uint4*)(Ks + so + 16 * 528) = rk2; *(uint4*)(Qs + so + 24 * 528) = rq3; *(uint4*)(Ks + so + 24 * 528) = rk3;
      }
      *(uint4*)(Vs + (ht >> 3) * 144 + (ht & 7) * 16) = rv;
      SCAN_GLOAD(row0(step + 1 < 136 ? step + 1 : step));
      const bool second = step < 8 ? step >= 4 : step >= 72;
      u16* const odst = O + (size_t)(m0 + l15) * 2048 + h * 512 + vs * 64 + 16 * wq + 4 * g;
      uint2 pv0 = make_uint2(0u, 0u), pv1 = pv0;
      if (second) {
        const int ko = step < 8 ? 7 - step : 143 - step;
        const unsigned need = 4u * (unsigned)(3 * (ko + 1) + 1);
        while (__hip_atomic_load(octr, __ATOMIC_RELAXED, __HIP_MEMORY_SCOPE_WORKGROUP) < need) __builtin_amdgcn_s_sleep(1);
        asm volatile("" ::: "memory");
        pv0 = *(const uint2*)odst; pv1 = *(const uint2*)(odst + (size_t)16 * 2048);
      }
      __builtin_amdgcn_sched_barrier(0);
      half_barrier(hctr, 4u * (++nbar), lane);
      {
        f32x4 sc = (f32x4){0.f, 0.f, 0.f, 0.f}, sc2 = sc;
        const char* kp = Ks + (16 * (wq >> 1) + l15) * 528 + g * 16; const char* qp = Qs + (16 * (wq & 1) + l15) * 528 + g * 16;
        bf16x8 kfr[8], qfr[8];
#pragma unroll
        for (int kk = 0; kk < 8; ++kk) { kfr[kk] = *(const bf16x8*)(kp + kk * 64); qfr[kk] = *(const bf16x8*)(qp + kk * 64); }
#pragma unroll
        for (int kk = 0; kk < 8; kk += 2) { sc = mfma16(kfr[kk], qfr[kk], sc); sc2 = mfma16(kfr[kk + 1], qfr[kk + 1], sc2); }
        sc[0] += sc2[0]; sc[1] += sc2[1]; sc[2] += sc2[2]; sc[3] += sc2[3];
        uint2 u; u.x = pk2(sc[0] * dmask[0], sc[1] * dmask[1]); u.y = pk2(sc[2] * dmask[2], sc[3] * dmask[3]);
        *(uint2*)(Ps + (16 * (wq & 1) + l15) * 80 + (16 * (wq >> 1) + 4 * g) * 2) = u;
      }
      half_barrier(hctr, 4u * (++nbar), lane);
      f32x4 oa[2], ob[2]; oa[0] = (f32x4){0.f, 0.f, 0.f, 0.f}; oa[1] = oa[0]; ob[0] = oa[0]; ob[1] = oa[0];
      {
        bf16x8 qf[2][2];
#define SCAN_LOADQ(dst_, pp_) _Pragma("unroll") for (int ti = 0; ti < 2; ++ti) { \
          const char* qb_ = Qs + (16 * ti + l15) * 528 + (32 * (pp_) + 4 * g) * 2; \
          const uint2 lo_ = *(const uint2*)qb_, hi_ = *(const uint2*)(qb_ + 32); \
          uint4 u_; u_.x = lo_.x; u_.y = lo_.y; u_.z = hi_.x; u_.w = hi_.y; dst_[ti] = __builtin_bit_cast(bf16x8, u_); }
        SCAN_LOADQ(qf[0], 0);
#pragma unroll
        for (int pp = 0; pp < 8; ++pp) {
          if (pp + 1 < 8) { SCAN_LOADQ(qf[(pp + 1) & 1], pp + 1); }
          float sv[8];
#pragma unroll
          for (int e = 0; e < 4; ++e) { sv[e] = S[2 * pp][e]; sv[4 + e] = S[2 * pp + 1][e]; }
          const bf16x8 af = pack8(sv);
          if (pp & 1) { ob[0] = mfma16(af, qf[pp & 1][0], ob[0]); ob[1] = mfma16(af, qf[pp & 1][1], ob[1]); }
          else { oa[0] = mfma16(af, qf[pp & 1][0], oa[0]); oa[1] = mfma16(af, qf[pp & 1][1], oa[1]); }
          __builtin_amdgcn_sched_barrier(0);
        }
#pragma unroll
        for (int ti = 0; ti < 2; ++ti) { oa[ti][0] += ob[ti][0]; oa[ti][1] += ob[ti][1]; oa[ti][2] += ob[ti][2]; oa[ti][3] += ob[ti][3]; }
      }
#pragma unroll
      for (int ti = 0; ti < 2; ++ti) { oa[ti][0] *= qdec[ti]; oa[ti][1] *= qdec[ti]; oa[ti][2] *= qdec[ti]; oa[ti][3] *= qdec[ti]; }
      const int q4 = l15 >> 2, p4 = l15 & 3;
      const char* vb = Vs + (8 * g + q4) * 144 + (16 * wq + 4 * p4) * 2;
      const bf16x8 vf = cat8(tr_read(vb), tr_read(vb + 4 * 144));
#pragma unroll
      for (int ti = 0; ti < 2; ++ti) oa[ti] = mfma16(vf, *(const bf16x8*)(Ps + (16 * ti + l15) * 80 + g * 16), oa[ti]);
#pragma unroll
      for (int ti = 0; ti < 2; ++ti) {
        u16* dst = odst + (size_t)(16 * ti) * 2048;
        const uint2 pv = ti ? pv1 : pv0;
        const float o0 = oa[ti][0] + bf2f((u16)(pv.x & 0xffff)), o1 = oa[ti][1] + bf2f((u16)(pv.x >> 16));
        const float o2 = oa[ti][2] + bf2f((u16)(pv.y & 0xffff)), o3 = oa[ti][3] + bf2f((u16)(pv.y >> 16));
        uint2 u; u.x = pk2(o0, o1); u.y = pk2(o2, o3);
        *(uint2*)dst = u;
      }
      {
        float sv[8];
#pragma unroll
        for (int e = 0; e < 8; ++e) sv[e] = bf2f((u16)vf[e]) * kdec[e];
        const bf16x8 vsf = pack8(sv);
        const char* kb = Ks + (8 * g + q4) * 528 + (4 * p4) * 2;
        bf16x8 kf[2][4];
#define SCAN_LOADK(dst_, cb_) _Pragma("unroll") for (int c4 = 0; c4 < 4; ++c4) dst_[c4] = cat8(tr_read(kb + ((cb_) * 4 + c4) * 32), tr_read(kb + ((cb_) * 4 + c4) * 32 + 4 * 528))
        SCAN_LOADK(kf[0], 0);
#pragma unroll
        for (int cb = 0; cb < 4; ++cb) {
          if (cb + 1 < 4) { SCAN_LOADK(kf[(cb + 1) & 1], cb + 1); }
#pragma unroll
          for (int c4 = 0; c4 < 4; ++c4) {
            const int c = cb * 4 + c4;
            f32x4 sc = S[c]; sc[0] *= gC; sc[1] *= gC; sc[2] *= gC; sc[3] *= gC;
            S[c] = mfma16(kf[cb & 1][c4], vsf, sc);
          }
          __builtin_amdgcn_sched_barrier(0);
        }
      }
    }
  }
}

DI void finish_phase(const Params& p, int bid, int nblk) {
  u16* O = (u16*)(p.ws + WS_O); const u16* G = (const u16*)(p.ws + WS_P);
  const int tid_ = opaque_tid(); const int lane = tid_ & 63, w = tid_ >> 6;
  for (int m = bid * NWV + w; m < M_ALL; m += nblk * NWV) {
    const size_t base = (size_t)m * 2048 + lane * 8;
    uint4 ov[4], gv[4];
#pragma unroll
    for (int h = 0; h < 4; ++h) { ov[h] = *(const uint4*)(O + base + h * 512); gv[h] = *(const uint4*)(G + base + h * 512); }
#pragma unroll
    for (int h = 0; h < 4; ++h) {
      float o[8], gg[8];
      const unsigned ou[4] = {ov[h].x, ov[h].y, ov[h].z, ov[h].w}, gu[4] = {gv[h].x, gv[h].y, gv[h].z, gv[h].w};
#pragma unroll
      for (int e = 0; e < 4; ++e) { o[2 * e] = bf2f((u16)(ou[e] & 0xffff)); o[2 * e + 1] = bf2f((u16)(ou[e] >> 16)); gg[2 * e] = bf2f((u16)(gu[e] & 0xffff)); gg[2 * e + 1] = bf2f((u16)(gu[e] >> 16)); }
      float s = 0.f;
#pragma unroll
      for (int e = 0; e < 8; ++e) s += o[e];
#pragma unroll
      for (int x = 32; x >= 1; x >>= 1) s += __shfl_xor(s, x);
      const float mu = s * (1.f / 512.f);
      float q = 0.f;
#pragma unroll
      for (int e = 0; e < 8; ++e) { o[e] -= mu; q += o[e] * o[e]; }
#pragma unroll
      for (int x = 32; x >= 1; x >>= 1) q += __shfl_xor(q, x);
      const float rstd = rsqrtf(q * (1.f / 512.f) + 1e-5f);
      float r[8];
#pragma unroll
      for (int e = 0; e < 8; ++e) r[e] = o[e] * rstd * gg[e];
      uint4 u; u.x = pk2(r[0], r[1]); u.y = pk2(r[2], r[3]); u.z = pk2(r[4], r[5]); u.w = pk2(r[6], r[7]);
      *(uint4*)(O + base + h * 512) = u;
    }
  }
}

struct KV4 { bf16x8 ka, kb, v0, v1; };
DI KV4 nat_load(const u16* Kh, const u16* Vt, size_t bh, int tb, int l15, int g) {
  KV4 r;
  const u16* kp = Kh + ((bh * 4 + g) * TBN + tb + l15) * 8;
  r.ka = *(const bf16x8*)kp; r.kb = *(const bf16x8*)(kp + 128);
  const u16* vp = Vt + ((bh * (TBN / 4) + (tb >> 2) + g) * 32 + l15) * 4;
  const uint2 a0 = *(const uint2*)vp, a1 = *(const uint2*)(vp + 512), b0 = *(const uint2*)(vp + 64), b1 = *(const uint2*)(vp + 512 + 64);
  uint4 u; u.x = a0.x; u.y = a0.y; u.z = a1.x; u.w = a1.y; r.v0 = __builtin_bit_cast(bf16x8, u);
  u.x = b0.x; u.y = b0.y; u.z = b1.x; u.w = b1.y; r.v1 = __builtin_bit_cast(bf16x8, u);
  return r;
}
template <bool FIRST, bool BIAS>
DI void nat_compute2(const KV4 ka_, const KV4 kb_, bf16x8 qf, const float* browA, const float* browB, const int (&bidx)[8], unsigned vmask,
                     float& mref, float& lsum, f32x4& oa0, f32x4& oa1, f32x4& ob0, f32x4& ob1) {
  const f32x4 z = (f32x4){0.f, 0.f, 0.f, 0.f};
  const f32x4 sa0 = mfma16(ka_.ka, qf, z), sb0 = mfma16(ka_.kb, qf, z), sa1 = mfma16(kb_.ka, qf, z), sb1 = mfma16(kb_.kb, qf, z);
  float s[16];
#pragma unroll
  for (int e = 0; e < 4; ++e) { s[e] = sa0[e]; s[4 + e] = sb0[e]; s[8 + e] = sa1[e]; s[12 + e] = sb1[e]; }
  if (BIAS) {
    float bv[16];
#pragma unroll
    for (int e = 0; e < 8; ++e) { bv[e] = browA[bidx[e]]; bv[8 + e] = browB[bidx[e]]; }
#pragma unroll
    for (int e = 0; e < 16; ++e) s[e] = ((vmask >> (e & 7)) & 1u) ? s[e] + bv[e] : -1e30f;
  }
  if (FIRST) {
    float tm = s[0];
#pragma unroll
    for (int e = 1; e < 16; ++e) tm = fmaxf(tm, s[e]);
    tm = fmaxf(tm, __shfl_xor(tm, 16)); tm = fmaxf(tm, __shfl_xor(tm, 32));
    mref = tm;
  }
  float ps = 0.f;
#pragma unroll
  for (int e = 0; e < 16; ++e) { s[e] = __builtin_amdgcn_exp2f(fminf(s[e] - mref, 100.f)); ps += s[e]; }
  lsum += ps;
  const bf16x8 pfA = pack8(s), pfB = pack8(s + 8);
  oa0 = mfma16(ka_.v0, pfA, oa0); oa1 = mfma16(ka_.v1, pfA, oa1);
  ob0 = mfma16(kb_.v0, pfB, ob0); ob1 = mfma16(kb_.v1, pfB, ob1);
}

DI void nat_phase(const Params& p, int jl, bool ctx_out, char* lds, int bid, int nblk) {
  const u16* Qh = (const u16*)(p.ws + WS_P); const u16* Kh = Qh + 35651584; const u16* Vt = Kh + 35651584;
  u16* O = (u16*)(p.ws + WS_O);
  float* rpall = (float*)lds;
  const int tid = opaque_tid(), lane = tid & 63, w = tid >> 6, l15 = lane & 15, g = lane >> 4;
  const int w4 = w & 3;
  __syncthreads();
  for (int i = tid; i < 32 * 465; i += NTHR) rpall[i] = p.nat_rpb[(size_t)jl * 32 * 465 + i] * 1.4426950408889634f;
  __syncthreads();
  const int nitems = 8192 + (ctx_out ? 512 : 0);
  for (int item = bid; item < nitems; item += nblk) {
    int b, h, r = 0, qg = 0; const bool isctx = item >= 8192;
    if (!isctx) { const int pair = (item >> 8) * 8 + (item & 7); r = ((item >> 3) & 31) * 2 + (w >> 2); b = pair >> 5; h = pair & 31; }
    else { const int it = item - 8192; b = it >> 6; h = (it >> 1) & 31; qg = (it & 1) * 8 + w; }
    const float* rp = rpall + h * 465;
    const size_t bh = (size_t)(b * 32 + h);
    const int tq = isctx ? 4096 + 16 * qg + l15 : r * 64 + 16 * w4 + l15;
    const bf16x8 qf = *(const bf16x8*)(Qh + ((bh * 4 + g) * TBN + tq) * 8);
    float mrun = -1e30f, lsum = 0.f; f32x4 o0 = (f32x4){0.f, 0.f, 0.f, 0.f}, o1 = o0;
    const int rs = min(max(r - 4, 0), 56), co = min(max(16 * w4 - 8, 0), 32), qc = 16 * w4 + l15, cs = min(max(qc - 8, 0), 48);
    int bidx[8]; unsigned vmask = 0;
#pragma unroll
    for (int e = 0; e < 8; ++e) {
      const int kc = co + 4 * g + (e & 3) + (e >> 2) * 16; const bool valid = kc >= cs && kc < cs + 16;
      bidx[e] = min(max(kc - qc + 15, 0), 30); vmask |= valid ? (1u << e) : 0u;
    }
#define NAT_TB(t_) ((t_) < 8 ? (rs + (t_)) * 64 + co : 4096 + 32 * ((t_) - 8))
    f32x4 p0 = (f32x4){0.f, 0.f, 0.f, 0.f}, p1 = p0;
#define NAT_BROW(t_) (rp + (rs + (t_) - r + 7) * 31)
#define NAT_RUN(T0_) do { \
      KV4 kq_[2][2]; \
      kq_[0][0] = nat_load(Kh, Vt, bh, NAT_TB(T0_), l15, g); kq_[0][1] = nat_load(Kh, Vt, bh, NAT_TB((T0_) + 1), l15, g); \
      _Pragma("unroll") for (int t = (T0_); t < 16; t += 2) { \
        const int pb_ = ((t - (T0_)) >> 1) & 1; \
        if (t + 2 < 16) { kq_[pb_ ^ 1][0] = nat_load(Kh, Vt, bh, NAT_TB(t + 2), l15, g); kq_[pb_ ^ 1][1] = nat_load(Kh, Vt, bh, NAT_TB(t + 3), l15, g); } \
        __builtin_amdgcn_sched_barrier(0); \
        if (t == (T0_)) { if (t < 8) nat_compute2<true, true>(kq_[pb_][0], kq_[pb_][1], qf, NAT_BROW(t), NAT_BROW(t + 1), bidx, vmask, mrun, lsum, o0, o1, p0, p1); \
                          else nat_compute2<true, false>(kq_[pb_][0], kq_[pb_][1], qf, nullptr, nullptr, bidx, vmask, mrun, lsum, o0, o1, p0, p1); } \
        else { if (t < 8) nat_compute2<false, true>(kq_[pb_][0], kq_[pb_][1], qf, NAT_BROW(t), NAT_BROW(t + 1), bidx, vmask, mrun, lsum, o0, o1, p0, p1); \
               else nat_compute2<false, false>(kq_[pb_][0], kq_[pb_][1], qf, nullptr, nullptr, bidx, vmask, mrun, lsum, o0, o1, p0, p1); } \
      } } while (0)
    if (!isctx) NAT_RUN(0); else NAT_RUN(8);
    o0[0] += p0[0]; o0[1] += p0[1]; o0[2] += p0[2]; o0[3] += p0[3]; o1[0] += p1[0]; o1[1] += p1[1]; o1[2] += p1[2]; o1[3] += p1[3];
    lsum += __shfl_xor(lsum, 16); lsum += __shfl_xor(lsum, 32);
    const float inv = 1.f / lsum;
    const int m = isctx ? M_LAT + b * 256 + 16 * qg + l15 : b * 4096 + tq;
    u16* dst = O + (size_t)m * 1024 + h * 32 + 4 * g;
    uint2 u; u.x = pk2(o0[0] * inv, o0[1] * inv); u.y = pk2(o0[2] * inv, o0[3] * inv); *(uint2*)dst = u;
    u.x = pk2(o1[0] * inv, o1[1] * inv); u.y = pk2(o1[2] * inv, o1[3] * inv); *(uint2*)(dst + 16) = u;
  }
}


#define XB_TMO      128
#define XB_XCNT(j)  (256  + 64 * (j))
#define XB_XSUB(j)  (1280 + 64 * (j))
#define XB_XGEN(j)  (2304 + 64 * (j))
#define XB_TOP      3328
#define XB_TOPGEN   3392
#define XCD_BAR_WORDS 3456
#define XB_SPIN_CAP (1u << 22)
#define LAS __attribute__((address_space(3)))
DI unsigned xb_ld(unsigned* p) { return __hip_atomic_load(p, __ATOMIC_RELAXED, __HIP_MEMORY_SCOPE_AGENT); }
DI unsigned xb_add(unsigned* p, unsigned v) { return __hip_atomic_fetch_add(p, v, __ATOMIC_RELAXED, __HIP_MEMORY_SCOPE_AGENT); }
DI unsigned xb_xcc_id() { return (unsigned)__builtin_amdgcn_s_getreg((3 << 11) | 20) & 0xFu; }
#define XB_SPIN(cond, bar) do { unsigned _sp = 0; while (cond) { __builtin_amdgcn_s_sleep(1); \
    if ((++_sp & 255u) == 0u) { if (xb_ld(&(bar)[XB_TMO])) break; if (_sp > XB_SPIN_CAP) { atomicAdd(&(bar)[XB_TMO], 1u); break; } } } } while (0)
struct XcdBarrier { unsigned* bar; unsigned x; volatile LAS unsigned* st; };
DI XcdBarrier xcd_barrier_post(unsigned* bar, volatile LAS unsigned* st) {
  XcdBarrier b; b.bar = bar; b.x = xb_xcc_id(); b.st = st;
  if (threadIdx.x == 0) (void)xb_add(&bar[XB_XCNT(b.x)], 1u);
  return b;
}
DI void xcd_barrier_complete(unsigned* bar, unsigned x, unsigned& nloc, unsigned& nx) {
  const unsigned G = gridDim.x * gridDim.y * gridDim.z;
  unsigned sum, cnt, mine, sp = 0u;
  for (;;) {
    sum = 0u; cnt = 0u; mine = 0u;
#pragma unroll
    for (unsigned j = 0; j < 16; ++j) { const unsigned c = xb_ld(&bar[XB_XCNT(j)]); sum += c; cnt += (c > 0u) ? 1u : 0u; mine = (j == x) ? c : mine; }
    if (sum == G) break;
    __builtin_amdgcn_s_sleep(1);
    if ((++sp & 255u) == 0u) { if (xb_ld(&bar[XB_TMO])) break; if (sp > XB_SPIN_CAP) { atomicAdd(&bar[XB_TMO], 1u); break; } }
  }
  nloc = mine > 0u ? mine : 1u; nx = cnt > 0u ? cnt : 1u;
}
DI void xcd_barrier(const XcdBarrier& b) {
  asm volatile("s_waitcnt vmcnt(0)" ::: "memory");
  __syncthreads();
  if (threadIdx.x == 0) {
    unsigned* bar = b.bar;
    __builtin_amdgcn_s_waitcnt(0);
    unsigned nloc = b.st[0], nx = b.st[1];
    if (nloc == 0u) { xcd_barrier_complete(bar, b.x, nloc, nx); b.st[0] = nloc; b.st[1] = nx; }
    const unsigned old = xb_add(&bar[XB_XSUB(b.x)], 1u);
    const unsigned gen = old / nloc;
    if (old + 1u == (gen + 1u) * nloc) {
      __builtin_amdgcn_fence(__ATOMIC_RELEASE, "agent");
      asm volatile("s_waitcnt vmcnt(0)" ::: "memory");
      const unsigned og = xb_add(&bar[XB_TOP], 1u);
      const unsigned tg = og / nx;
      if (og + 1u == (tg + 1u) * nx) xb_add(&bar[XB_TOPGEN], 1u);
      else XB_SPIN(xb_ld(&bar[XB_TOPGEN]) == tg, bar);
      __builtin_amdgcn_fence(__ATOMIC_ACQUIRE, "agent");
      xb_add(&bar[XB_XGEN(b.x)], 1u);
      asm volatile("s_waitcnt vmcnt(0)" ::: "memory");
    } else {
      XB_SPIN(xb_ld(&bar[XB_XGEN(b.x)]) == gen, bar);
      __builtin_amdgcn_fence(__ATOMIC_ACQUIRE, "agent");
      asm volatile("s_waitcnt vmcnt(0)" ::: "memory");
    }
  }
  __syncthreads();
}

__global__ void __launch_bounds__(512, 2) mega(Params p) {
  extern __shared__ __attribute__((aligned(16))) char lds[];
  cg::grid_group grid = cg::this_grid();
  const int bid = blockIdx.x, nblk = gridDim.x;
  __shared__ __attribute__((aligned(16))) unsigned xb_st[4];
  if (threadIdx.x < 4) xb_st[threadIdx.x] = 0u;
  __syncthreads();
  const XcdBarrier xb = xcd_barrier_post((unsigned*)(p.ws + WS_END), (volatile LAS unsigned*)xb_st);
  const float* mod = (const float*)(p.ws + WS_MOD);
  u16* HM = (u16*)(p.ws + WS_HM); u16* PB = (u16*)(p.ws + WS_P); u16* OB = (u16*)(p.ws + WS_O);
  u16* WA = (u16*)(p.ws + WS_WA); u16* WAO = (u16*)(p.ws + WS_WAO);

  mod_phase(p, lds, bid, nblk);
  conv_WA(p, 0, lds, bid, nblk);
  grid.sync();
  ln_phase(p, false, nullptr, nullptr, mod, 0, true, M_ALL, bid, nblk);
  xcd_barrier(xb);
  for (int i = 0; i < 4; ++i) {
    const bool last = i == 3; const int jl = i >> 1; const int Mr = last ? M_LAT : M_ALL;
    const float* modl = mod + (size_t)i * 9 * 6144;
    GArgs go{};
    if ((i & 1) == 0) {
      { GArgs ga{}; ga.A = HM; ga.lda = 1024; ga.Bt = WA; ga.ldb = 1024; ga.M = M_LAT; ga.N = 4096; ga.K = 1024; ga.out = PB; ga.ldo = 4096;
        gemm_phase<EP_RET_QKV, 4>(p, ga, lds, bid, nblk);
        ga.m0 = M_LAT; ga.M = M_ALL - M_LAT; gemm_phase<EP_RET_QKV, 2>(p, ga, lds, bid, nblk); }
      xcd_barrier(xb);
      scan_phase(p, jl, lds, bid, nblk);
      xcd_barrier(xb);
      if (DUP_M) { scan_phase(p, jl, lds, bid, nblk); xcd_barrier(xb); }
      { GArgs ga{}; ga.A = HM; ga.lda = 1024; ga.Bt = WA + (size_t)4096 * 1024; ga.ldb = 1024; ga.M = M_LAT; ga.N = 2048; ga.K = 1024; ga.out = PB; ga.ldo = 2048;
        gemm_phase<EP_RET_G, 4>(p, ga, lds, bid, nblk);
        ga.m0 = M_LAT; ga.M = M_ALL - M_LAT; gemm_phase<EP_RET_G, 2>(p, ga, lds, bid, nblk); }
      xcd_barrier(xb);
      finish_phase(p, bid, nblk);
      xcd_barrier(xb);
      go.A = OB; go.lda = 2048; go.Bt = WAO; go.ldb = 2048; go.K = 2048;
    } else {
      { GArgs ga{}; ga.A = HM; ga.lda = 1024; ga.Bt = WA; ga.ldb = 1024; ga.M = M_LAT; ga.N = 3072; ga.K = 1024;
        gemm_phase<EP_NAT, 4>(p, ga, lds, bid, nblk);
        ga.m0 = M_LAT; ga.M = M_ALL - M_LAT; gemm_phase<EP_NAT, 2>(p, ga, lds, bid, nblk); }
      xcd_barrier(xb);
      nat_phase(p, jl, !last, lds, bid, nblk);
      xcd_barrier(xb);
      if (DUP_M) { nat_phase(p, jl, !last, lds, bid, nblk); xcd_barrier(xb); }
      go.A = OB; go.lda = 1024; go.Bt = WAO; go.ldb = 1024; go.K = 1024;
    }
    go.M = Mr; go.N = 1024; go.gate = modl + 2048;
    go.M = M_LAT; gemm_phase<EP_RESID, 4>(p, go, lds, bid, nblk);
    if (!last) { go.m0 = M_LAT; go.M = M_ALL - M_LAT; go.out = PB; gemm_phase<EP_RESID_SK, 2>(p, go, lds, bid, nblk); }
    xcd_barrier(xb);
    conv_WB(p, i, lds, bid, nblk);
    ln_phase(p, true, p.ln_g + (size_t)(i * 2) * 1024, p.ln_b + (size_t)(i * 2) * 1024, modl, 3072, true, Mr, bid, nblk, (const float*)PB);
    xcd_barrier(xb);
    { GArgs ga{}; ga.A = HM; ga.lda = 1024; ga.Bt = OB; ga.ldb = 1024; ga.M = M_LAT; ga.N = 4096; ga.K = 1024; ga.out = PB; ga.ldo = 4096;
      gemm_phase<EP_RELU2, 4>(p, ga, lds, bid, nblk);
      if (!last) { ga.m0 = M_LAT; ga.M = M_ALL - M_LAT; gemm_phase<EP_RELU2, 2>(p, ga, lds, bid, nblk); } }
    xcd_barrier(xb);
    { GArgs ga{}; ga.A = PB; ga.lda = 4096; ga.Bt = OB + (size_t)4096 * 1024; ga.ldb = 4096; ga.M = Mr; ga.N = 1024; ga.K = 4096; ga.gate = modl + 5120;
      ga.M = M_LAT; gemm_phase<EP_RESID, 4>(p, ga, lds, bid, nblk);
      if (!last) { ga.m0 = M_LAT; ga.M = M_ALL - M_LAT; ga.out = (u16*)(p.ws + WS_O + 16 * MiB); gemm_phase<EP_RESID_SK, 2>(p, ga, lds, bid, nblk); } }
    xcd_barrier(xb);
    if (!last) conv_WA(p, i + 1, lds, bid, nblk);
    ln_phase(p, true, p.ln_g + (size_t)(i * 2 + 1) * 1024, p.ln_b + (size_t)(i * 2 + 1) * 1024, modl + 9 * 6144, 0, !last, Mr, bid, nblk, (const float*)(p.ws + WS_O + 16 * MiB));
    if (!last) xcd_barrier(xb);
  }
}

extern "C" void kernel_launch(void* const* d_in, const int* in_sizes, int n_in, void* d_out, int out_size, void* d_ws, size_t ws_size, hipStream_t stream) {
  static int grid_blocks = 0;
  if (!grid_blocks) {
    int dev = 0, cus = 0, per_cu = 0;
    hipGetDevice(&dev);
    hipDeviceGetAttribute(&cus, hipDeviceAttributeMultiprocessorCount, dev);
    hipFuncSetAttribute((const void*)mega, hipFuncAttributeMaxDynamicSharedMemorySize, LDS_BYTES);
    hipOccupancyMaxActiveBlocksPerMultiprocessor(&per_cu, (const void*)mega, NTHR, LDS_BYTES);
    if (per_cu > 1) per_cu = 1;
    if (per_cu < 1) per_cu = 1;
    grid_blocks = cus * per_cu;
    if (ws_size < WS_END + 65536) fprintf(stderr, "kernel_launch: workspace too small: %zu < %zu\n", ws_size, (size_t)WS_END);
  }
  Params p{};
  p.x = (const float*)d_in[0]; p.c = (const float*)d_in[1]; p.ctx = (const float*)d_in[2]; p.c_ctx = (const float*)d_in[3];
  p.ada_w = (const float*)d_in[4]; p.ada_b = (const float*)d_in[5]; p.ret_w_in = (const float*)d_in[6]; p.ret_w_o = (const float*)d_in[7];
  p.ret_decay = (const float*)d_in[8]; p.nat_w_in = (const float*)d_in[9]; p.nat_w_o = (const float*)d_in[10]; p.nat_rpb = (const float*)d_in[11];
  p.mlp_w1 = (const float*)d_in[12]; p.mlp_w2 = (const float*)d_in[13]; p.ln_g = (const float*)d_in[14]; p.ln_b = (const float*)d_in[15];
  p.out = (float*)d_out; p.ws = (char*)d_ws;
  (void)hipMemsetAsync((char*)d_ws + WS_END, 0, XCD_BAR_WORDS * sizeof(unsigned), stream);
  void* args[] = {&p};
  hipError_t e = hipLaunchCooperativeKernel((const void*)mega, dim3(grid_blocks), dim3(NTHR), args, LDS_BYTES, stream);
  if (e != hipSuccess) fprintf(stderr, "cooperative launch failed: %s (grid %d)\n", hipGetErrorString(e), grid_blocks);
}
```

```cpp
#include <hip/hip_runtime.h>
#include <hip/hip_cooperative_groups.h>
#include <cstdio>
namespace cg = cooperative_groups;

#define DI __device__ __forceinline__
#ifndef DUP_G
#define DUP_G 0
#endif
#ifndef DUP_M
#define DUP_M 0
#endif
typedef unsigned short u16;
typedef short bf16x8 __attribute__((ext_vector_type(8)));
typedef short s16x4 __attribute__((ext_vector_type(4)));
typedef float f32x4 __attribute__((ext_vector_type(4)));
typedef __attribute__((address_space(3))) s16x4* lds_s16x4_ptr;

constexpr int M_LAT = 32768, M_ALL = 34816, DM = 1024, TBN = 4352;
constexpr float DN_ALPHA = 1.681792830507429f;
constexpr size_t MiB = 1048576;
constexpr size_t WS_WA = 0, WS_WAO = 12582912, WS_MOD = 16 * MiB, WS_ROPE = 16 * MiB + 917504, WS_XCTX = 17 * MiB,
                 WS_HM = 25 * MiB, WS_P = 93 * MiB, WS_O = 365 * MiB, WS_END = 501 * MiB;
constexpr int LDS_BYTES = 131072;
constexpr int NTHR = 512, NWV = 8;

struct Params {
  const float *x, *c, *ctx, *c_ctx, *ada_w, *ada_b, *ret_w_in, *ret_w_o, *ret_decay, *nat_w_in, *nat_w_o, *nat_rpb, *mlp_w1, *mlp_w2, *ln_g, *ln_b;
  float* out; char* ws;
};

DI u16 f2bf(float f) { return __builtin_bit_cast(u16, (__bf16)f); }
DI float bf2f(u16 h) { return __uint_as_float(((unsigned)h) << 16); }
typedef float f32x2 __attribute__((ext_vector_type(2)));
typedef __bf16 bf16x2_t __attribute__((ext_vector_type(2)));
DI unsigned pk2(float a, float b) { f32x2 v = {a, b}; return __builtin_bit_cast(unsigned, __builtin_convertvector(v, bf16x2_t)); }
DI float siluf(float v) { return v / (1.f + __expf(-v)); }
DI f32x4 mfma16(bf16x8 a, bf16x8 b, f32x4 c) { return __builtin_amdgcn_mfma_f32_16x16x32_bf16(a, b, c, 0, 0, 0); }
DI s16x4 tr_read(const char* p) { return __builtin_bit_cast(s16x4, __builtin_amdgcn_ds_read_tr16_b64_v4i16((lds_s16x4_ptr)p)); }
DI bf16x8 cat8(s16x4 a, s16x4 b) { bf16x8 r; r[0]=a[0]; r[1]=a[1]; r[2]=a[2]; r[3]=a[3]; r[4]=b[0]; r[5]=b[1]; r[6]=b[2]; r[7]=b[3]; return r; }
DI bf16x8 pack8(const float* s) {
  uint4 u; u.x = pk2(s[0], s[1]); u.y = pk2(s[2], s[3]); u.z = pk2(s[4], s[5]); u.w = pk2(s[6], s[7]);
  return __builtin_bit_cast(bf16x8, u);
}
DI float* xrow(const Params& p, int m) { return m < M_LAT ? p.out + (size_t)m * DM : (float*)(p.ws + WS_XCTX) + (size_t)(m - M_LAT) * DM; }
DI int opaque_tid() { int t = threadIdx.x; asm volatile("" : "+v"(t)); return t; }
DI int grp_of(int m) { return m < M_LAT ? (m >> 12) : 8; }

DI void conv_tile(const float* __restrict__ W, int K, int N, u16* __restrict__ Wt, bool permq, int tile, char* lds) {
  const int ntn = N >> 6; const int kt = tile / ntn, nt = tile - kt * ntn;
  const int tid = opaque_tid() & 255;
  u16* T = (u16*)lds + (opaque_tid() >> 8) * 4352;
  __syncthreads();
  {
    const int c4 = (tid & 15) * 4, r0 = tid >> 4;
#pragma unroll
    for (int j = 0; j < 4; ++j) {
      const int kr = r0 + 16 * j;
      const float4 v = *(const float4*)(W + (size_t)(kt * 64 + kr) * N + nt * 64 + c4);
      T[(c4 + 0) * 66 + kr] = f2bf(v.x); T[(c4 + 1) * 66 + kr] = f2bf(v.y); T[(c4 + 2) * 66 + kr] = f2bf(v.z); T[(c4 + 3) * 66 + kr] = f2bf(v.w);
    }
  }
  __syncthreads();
  {
    const int k8 = (tid & 7) * 8;
#pragma unroll
    for (int j = 0; j < 2; ++j) {
      const int nl = (tid >> 3) + 32 * j; int n = nt * 64 + nl;
      if (permq && n < 2048) { const int i = n & 127; n = (n & ~127) + 2 * (i & 63) + (i >> 6); }
      const unsigned* src = (const unsigned*)(T + nl * 66 + k8);
      uint4 u; u.x = src[0]; u.y = src[1]; u.z = src[2]; u.w = src[3];
      *(uint4*)(Wt + (size_t)n * K + kt * 64 + k8) = u;
    }
  }
}
DI void conv_weights(const float* W, int K, int N, u16* Wt, bool permq, char* lds, int bid, int nblk) {
  const int nt = (K >> 6) * (N >> 6);
  for (int t = bid * 2 + (opaque_tid() >> 8); t < nt; t += nblk * 2) conv_tile(W, K, N, Wt, permq, t, lds);
}
DI void conv_WA(const Params& p, int layer, char* lds, int bid, int nblk) {
  const int j = layer >> 1;
  u16* wa = (u16*)(p.ws + WS_WA); u16* wo = (u16*)(p.ws + WS_WAO);
  if ((layer & 1) == 0) {
    conv_weights(p.ret_w_in + (size_t)j * 1024 * 6144, 1024, 6144, wa, true, lds, bid, nblk);
    conv_weights(p.ret_w_o + (size_t)j * 2048 * 1024, 2048, 1024, wo, false, lds, bid, nblk);
  } else {
    conv_weights(p.nat_w_in + (size_t)j * 1024 * 3072, 1024, 3072, wa, false, lds, bid, nblk);
    conv_weights(p.nat_w_o + (size_t)j * 1024 * 1024, 1024, 1024, wo, false, lds, bid, nblk);
  }
}
DI void conv_WB(const Params& p, int layer, char* lds, int bid, int nblk) {
  u16* w1 = (u16*)(p.ws + WS_O); u16* w2 = w1 + (size_t)4096 * 1024;
  conv_weights(p.mlp_w1 + (size_t)layer * 1024 * 4096, 1024, 4096, w1, false, lds, bid, nblk);
  conv_weights(p.mlp_w2 + (size_t)layer * 4096 * 1024, 4096, 1024, w2, false, lds, bid, nblk);
}

DI void mod_phase(const Params& p, char* lds, int bid, int nblk) {
  float* sc = (float*)lds;
  float* red = sc + 9 * 1024;
  float* mod = (float*)(p.ws + WS_MOD);
  const int tid = opaque_tid();
  bool loaded = false;
  for (int item = bid; item < 4 * 192; item += nblk) {
    if (!loaded) {
      for (int i = tid; i < 9 * 1024; i += NTHR) { const float v = i < 8192 ? p.c[i] : p.c_ctx[i - 8192]; sc[i] = siluf(v); }
      loaded = true;
    }
    __syncthreads();
    const int l = item / 192, cgp = item - l * 192;
    const int col = tid & 31, ks = tid >> 5;
    const float* w = p.ada_w + (size_t)l * 1024 * 6144 + cgp * 32 + col;
    float acc[9];
#pragma unroll
    for (int g = 0; g < 9; ++g) acc[g] = 0.f;
#pragma unroll 8
    for (int k = ks * 64; k < ks * 64 + 64; ++k) {
      const float wv = w[(size_t)k * 6144];
#pragma unroll
      for (int g = 0; g < 9; ++g) acc[g] += sc[g * 1024 + k] * wv;
    }
#pragma unroll
    for (int g = 0; g < 9; ++g) red[(ks * 9 + g) * 32 + col] = acc[g];
    __syncthreads();
    for (int idx = tid; idx < 288; idx += NTHR) {
      const int g = idx >> 5, cc = idx & 31;
      float s = 0.f;
#pragma unroll
      for (int k8 = 0; k8 < 16; ++k8) s += red[(k8 * 9 + g) * 32 + cc];
      const int n = cgp * 32 + cc;
      mod[((size_t)l * 9 + g) * 6144 + n] = s + p.ada_b[l * 6144 + n];
    }
  }
  if (bid == nblk - 1) {
    float2* rope = (float2*)(p.ws + WS_ROPE);
    for (int i = tid; i < 4096; i += NTHR) {
      const int pos = i >> 6, pr = i & 63;
      const float inv = 1.0f / powf(10000.0f, (float)(2 * pr) / 128.0f);
      const float ang = (float)pos * inv;
      rope[i] = make_float2(cosf(ang), sinf(ang));
    }
  }
}

DI void ln_phase(const Params& p, bool do_ln, const float* lng, const float* lnb, const float* modn  ,
                 int sh_off, bool write_h, int rows, int bid, int nblk, const float* ypart = nullptr) {
  const int tid_ = opaque_tid(); const int lane = tid_ & 63, w = tid_ >> 6;
  u16* hm = (u16*)(p.ws + WS_HM);
  for (int m = bid * NWV + w; m < rows; m += nblk * NWV) {
    float* xr = xrow(p, m);
    const float* src = do_ln ? xr : (m < M_LAT ? p.x + (size_t)m * DM : p.ctx + (size_t)(m - M_LAT) * DM);
    float4 v[4];
#pragma unroll
    for (int j = 0; j < 4; ++j) v[j] = *(const float4*)(src + j * 256 + lane * 4);
    if (do_ln && m >= M_LAT) {
      const float* yr = ypart + (size_t)(m - M_LAT) * DM;
#pragma unroll
      for (int j = 0; j < 4; ++j) {
        float4 y = *(const float4*)(yr + j * 256 + lane * 4);
#pragma unroll
        for (int kp = 1; kp < 4; ++kp) { const float4 y2 = *(const float4*)(yr + (size_t)kp * 2048 * DM + j * 256 + lane * 4); y.x += y2.x; y.y += y2.y; y.z += y2.z; y.w += y2.w; }
        v[j].x = DN_ALPHA * v[j].x + y.x; v[j].y = DN_ALPHA * v[j].y + y.y; v[j].z = DN_ALPHA * v[j].z + y.z; v[j].w = DN_ALPHA * v[j].w + y.w;
      }
    }
    if (do_ln) {
      float s = 0.f;
#pragma unroll
      for (int j = 0; j < 4; ++j) s += v[j].x + v[j].y + v[j].z + v[j].w;
#pragma unroll
      for (int o = 32; o >= 1; o >>= 1) s += __shfl_xor(s, o);
      const float mu = s * (1.f / 1024.f);
      float q = 0.f;
#pragma unroll
      for (int j = 0; j < 4; ++j) { v[j].x -= mu; v[j].y -= mu; v[j].z -= mu; v[j].w -= mu; q += v[j].x * v[j].x + v[j].y * v[j].y + v[j].z * v[j].z + v[j].w * v[j].w; }
#pragma unroll
      for (int o = 32; o >= 1; o >>= 1) q += __shfl_xor(q, o);
      const float rstd = rsqrtf(q * (1.f / 1024.f) + 1e-5f);
#pragma unroll
      for (int j = 0; j < 4; ++j) {
        const float4 gg = *(const float4*)(lng + j * 256 + lane * 4), bb = *(const float4*)(lnb + j * 256 + lane * 4);
        v[j].x = v[j].x * rstd * gg.x + bb.x; v[j].y = v[j].y * rstd * gg.y + bb.y; v[j].z = v[j].z * rstd * gg.z + bb.z; v[j].w = v[j].w * rstd * gg.w + bb.w;
      }
    }
#pragma unroll
    for (int j = 0; j < 4; ++j) *(float4*)(xr + j * 256 + lane * 4) = v[j];
    if (write_h) {
      const float* mr = modn + (size_t)grp_of(m) * 6144 + sh_off;
#pragma unroll
      for (int j = 0; j < 4; ++j) {
        const float4 sh = *(const float4*)(mr + j * 256 + lane * 4), sc = *(const float4*)(mr + 1024 + j * 256 + lane * 4);
        uint2 u; u.x = pk2(v[j].x * (1.f + sc.x) + sh.x, v[j].y * (1.f + sc.y) + sh.y); u.y = pk2(v[j].z * (1.f + sc.z) + sh.z, v[j].w * (1.f + sc.w) + sh.w);
        *(uint2*)(hm + (size_t)m * DM + j * 256 + lane * 4) = u;
      }
    }
  }
}

enum { EP_RET_QKV = 0, EP_RET_G = 1, EP_NAT = 2, EP_RESID = 3, EP_RELU2 = 4, EP_RESID_SK = 5 };
struct GArgs {
  const u16* A; int lda; const u16* Bt; int ldb; int M, N, K; int m0;
  u16* out; int ldo; const float* gate;
};

DI int lds_byte2(int r, int c) { const int st = (r >> 4) * 2 + (c >> 5), ob = (r & 15) * 64 + (c & 31) * 2; return st * 1024 + (ob ^ (((ob >> 9) & 1) << 5)); }
DI void stage_rc2(int b, int& R, int& C) { const int st = b >> 10, sb = b & 1023, swz = sb ^ (((sb >> 9) & 1) << 5); R = (st >> 1) * 16 + swz / 64; C = (st & 1) * 32 + (swz % 64) / 2; }

template <int MODE, int NJ, bool DRY = false>
DI void gemm_phase(const Params& p, const GArgs& ga, char* lds, int bid, int nblk) {
  constexpr int SROWS = 64 * NJ, GLS = SROWS / 64;
  const int tid = opaque_tid(), lane = tid & 63, w = tid >> 6, wr = w >> 2, wc = w & 3, l15 = lane & 15, g = lane >> 4;
  const bool any_tr = MODE == EP_NAT;
  const int NTn = (any_tr ? 2048 : ga.N) / 256, MTn = ga.M / SROWS;
  const int n_norm = NTn * MTn;
  const int Rm = 256 / NTn, full_sw = (NTn == 4 || NTn == 8 || NTn == 16) ? (MTn / Rm) * 256 : 0;
  const int NTt = any_tr ? 1024 / SROWS : 1, MTt = ga.M / 256;
  constexpr int KSPLIT = MODE == EP_RESID_SK ? 4 : 1;
  const int ntiles = (n_norm + (any_tr ? NTt * MTt : 0)) * KSPLIT;
  constexpr int LPT = 2 + NJ / 2;
  const int grow = lane >> 2, gcol = (((lane & 3) ^ ((lane >> 5) * 3)) << 3);
  const int frd = l15 * 64 + ((g ^ (((l15 >> 3) & 1) * 3)) << 4);
  const int nk32 = (ga.K / KSPLIT) >> 5;
  for (int tu = bid; tu < ntiles; tu += nblk) {
    const int t = tu / KSPLIT, kpart = tu - t * KSPLIT;
    int f0, s0; const u16 *Fb, *Sb; int ldF, ldS; bool transposed = false;
    if (any_tr && t >= n_norm) {
      const int tt = t - n_norm, mt = tt / NTt, nt = tt - mt * NTt;
      transposed = true; f0 = ga.m0 + mt * 256; s0 = 2048 + nt * SROWS;
      Fb = ga.A + (size_t)f0 * ga.lda; ldF = ga.lda; Sb = ga.Bt + (size_t)s0 * ga.ldb; ldS = ga.ldb;
    } else {
      int mt, nt;
      if (nblk == 256 && t < full_sw) {
        const int r = t >> 8, x = t & 7, j = (t & 255) >> 3;
        if (NTn >= 8) { const int nx = NTn >> 3, cx = x % nx, rx = x / nx; nt = cx * 8 + (j & 7); mt = r * Rm + rx * 4 + (j >> 3); }
        else { nt = j & 3; mt = r * Rm + x * 8 + (j >> 2); }
      } else { mt = t / NTn; nt = t - mt * NTn; }
      f0 = nt * 256; s0 = ga.m0 + mt * SROWS;
      Fb = ga.Bt + (size_t)f0 * ga.ldb; ldF = ga.ldb; Sb = ga.A + (size_t)s0 * ga.lda; ldS = ga.lda;
    }
    const u16* Fg = Fb + (size_t)(16 * w + grow) * ldF + gcol + kpart * (ga.K / KSPLIT);
    const u16* Sg = Sb + (size_t)(16 * w + grow) * ldS + gcol + kpart * (ga.K / KSPLIT);
    size_t f128 = (size_t)128 * ldF, s128 = (size_t)128 * ldS;
    asm volatile("" : "+s"(f128), "+s"(s128));
    f32x4 acc[8][NJ];
#pragma unroll
    for (int i = 0; i < 8; ++i)
#pragma unroll
      for (int j = 0; j < NJ; ++j) acc[i][j] = (f32x4){0.f, 0.f, 0.f, 0.f};
#define GSTAGE(kt_) do { \
      const int kc_ = (kt_) < nk32 ? (kt_) : nk32 - 1; \
      char* sb_ = lds + ((kt_) & 3) * 32768 + w * 1024; const int ko_ = DRY ? 0 : (kc_ << 5); \
      const size_t kf_ = f128 + ko_, ks_ = s128 + ko_; \
      __builtin_amdgcn_global_load_lds((const unsigned*)(Fg + ko_), (unsigned*)(sb_), 16, 0, 0); \
      __builtin_amdgcn_global_load_lds((const unsigned*)(Fg + kf_), (unsigned*)(sb_ + 8192), 16, 0, 0); \
      __builtin_amdgcn_global_load_lds((const unsigned*)(Sg + ko_), (unsigned*)(sb_ + 16384), 16, 0, 0); \
      if (NJ == 4) __builtin_amdgcn_global_load_lds((const unsigned*)(Sg + ks_), (unsigned*)(sb_ + 16384 + 8192), 16, 0, 0); } while (0)
#define LOADB_(dst_, st_) do { const char* b_ = lds + (st_) * 32768 + 16384 + (wc * NJ) * 1024 + frd; \
      _Pragma("unroll") for (int j = 0; j < NJ; ++j) dst_[j] = *(const bf16x8*)(b_ + j * 1024); } while (0)
#define LOADA_(dst_, st_, ih_) do { const char* a_ = lds + (st_) * 32768 + (wr * 8 + (ih_) * 4) * 1024 + frd; \
      _Pragma("unroll") for (int i = 0; i < 4; ++i) dst_[i] = *(const bf16x8*)(a_ + i * 1024); } while (0)
#define MMA_(ih_, fa_, fb_) _Pragma("unroll") for (int i = 0; i < 4; ++i) _Pragma("unroll") for (int j = 0; j < NJ; ++j) acc[(ih_) * 4 + i][j] = mfma16(fa_[i], fb_[j], acc[(ih_) * 4 + i][j])
#define WAIT_LPT() do { if (LPT == 4) asm volatile("s_waitcnt vmcnt(4)" ::: "memory"); else asm volatile("s_waitcnt vmcnt(3)" ::: "memory"); } while (0)
    __builtin_amdgcn_s_barrier();
    GSTAGE(0); GSTAGE(1); GSTAGE(2);
    WAIT_LPT();
    __builtin_amdgcn_s_barrier();
    bf16x8 fbA[NJ], fbB[NJ], fa0[4], fa1[4];
    LOADB_(fbA, 0); LOADA_(fa0, 0, 0);
#pragma unroll 1
    for (int kt = 0; kt < nk32; ++kt) {
      WAIT_LPT(); __builtin_amdgcn_s_barrier();
      GSTAGE(kt + 3);
      LOADA_(fa1, kt & 3, 1); MMA_(0, fa0, fbA);
      __builtin_amdgcn_sched_barrier(0);
      LOADB_(fbB, (kt + 1) & 3); LOADA_(fa0, (kt + 1) & 3, 0); MMA_(1, fa1, fbA);
      __builtin_amdgcn_sched_barrier(0);
#pragma unroll
      for (int j = 0; j < NJ; ++j) fbA[j] = fbB[j];
    }
    asm volatile("s_waitcnt vmcnt(0)" ::: "memory");
    int el15 = l15, eg = g, ewr = wr, ewc = wc;
    asm volatile("" : "+v"(el15), "+v"(eg), "+v"(ewr), "+v"(ewc));
    if (DRY) { if (acc[0][0][0] != 1.2345e38f && acc[7][NJ - 1][3] != 3.2145e37f && acc[1][1][1] != 7.7e36f && acc[2][1][2] != 9.9e35f) continue; }
    if (MODE == EP_NAT && transposed) {
      u16* vt = (u16*)(p.ws + WS_P) + (size_t)2 * 35651584;
#pragma unroll
      for (int i = 0; i < 8; ++i) {
        const int m = f0 + ewr * 128 + 16 * i + 4 * eg;
        int b, tq; if (m < M_LAT) { b = m >> 12; tq = m & 4095; } else { b = (m - M_LAT) >> 8; tq = 4096 + ((m - M_LAT) & 255); }
#pragma unroll
        for (int j = 0; j < NJ; ++j) {
          const int n = s0 - 2048 + ewc * (16 * NJ) + 16 * j + el15; const int h = n >> 5, d = n & 31;
          uint2 u; u.x = pk2(acc[i][j][0], acc[i][j][1]); u.y = pk2(acc[i][j][2], acc[i][j][3]);
          *(uint2*)(vt + (((size_t)(b * 32 + h) * (TBN / 4) + (tq >> 2)) * 32 + d) * 4) = u;
        }
      }
    } else if (MODE == EP_RESID) {
      const int nb = f0 + ewr * 128 + 4 * eg;
      const float* gp = ga.gate + (size_t)grp_of(s0) * 6144 + nb;
      float4 gt[8];
#pragma unroll
      for (int i = 0; i < 8; ++i) gt[i] = *(const float4*)(gp + 16 * i);
#pragma unroll
      for (int j = 0; j < NJ; ++j) {
        float* xr = xrow(p, s0 + ewc * (16 * NJ) + 16 * j + el15) + nb;
        float4 xv[8];
#pragma unroll
        for (int i = 0; i < 8; ++i) xv[i] = *(const float4*)(xr + 16 * i);
#pragma unroll
        for (int i = 0; i < 8; ++i) {
          const f32x4 a = acc[i][j];
          float4 o; o.x = DN_ALPHA * xv[i].x + gt[i].x * a[0]; o.y = DN_ALPHA * xv[i].y + gt[i].y * a[1]; o.z = DN_ALPHA * xv[i].z + gt[i].z * a[2]; o.w = DN_ALPHA * xv[i].w + gt[i].w * a[3];
          *(float4*)(xr + 16 * i) = o;
        }
      }
    } else {
#pragma unroll
      for (int j = 0; j < NJ; ++j) {
        const int m = s0 + ewc * (16 * NJ) + 16 * j + el15;
#pragma unroll
        for (int i = 0; i < 8; ++i) {
          const int n = f0 + ewr * 128 + 16 * i + 4 * eg;
          f32x4 a = acc[i][j];
          if (MODE == EP_RELU2) {
            float r0 = fmaxf(a[0], 0.f), r1 = fmaxf(a[1], 0.f), r2 = fmaxf(a[2], 0.f), r3 = fmaxf(a[3], 0.f);
            uint2 u; u.x = pk2(r0 * r0, r1 * r1); u.y = pk2(r2 * r2, r3 * r3);
            *(uint2*)(ga.out + (size_t)m * ga.ldo + n) = u;
          } else if (MODE == EP_RET_G) {
            uint2 u; u.x = pk2(siluf(a[0]), siluf(a[1])); u.y = pk2(siluf(a[2]), siluf(a[3]));
            *(uint2*)(ga.out + (size_t)m * ga.ldo + n) = u;
          } else if (MODE == EP_RESID_SK) {
            float* yr = (float*)ga.out + ((size_t)kpart * 2048 + (m - M_LAT)) * DM + n;
            const float4 gt = *(const float4*)(ga.gate + (size_t)8 * 6144 + n);
            *(float4*)yr = make_float4(gt.x * a[0], gt.y * a[1], gt.z * a[2], gt.w * a[3]);
          } else if (MODE == EP_RESID) {
            float* xr = xrow(p, m) + n;
            const float4 xv = *(const float4*)xr;
            const float4 gt = *(const float4*)(ga.gate + (size_t)grp_of(m) * 6144 + n);
            float4 o; o.x = DN_ALPHA * xv.x + gt.x * a[0]; o.y = DN_ALPHA * xv.y + gt.y * a[1]; o.z = DN_ALPHA * xv.z + gt.z * a[2]; o.w = DN_ALPHA * xv.w + gt.w * a[3];
            *(float4*)xr = o;
          } else if (MODE == EP_RET_QKV) {
            if (n < 2048) {
              if (n >= 1024) { a[0] *= 0.0625f; a[1] *= 0.0625f; a[2] *= 0.0625f; a[3] *= 0.0625f; }
              if (m < M_LAT) {
                const int tk = m & 4095; const int pos = ((n >> 7) & 1) ? (tk & 63) : (tk >> 6);
                const float4 cs = *(const float4*)((const float*)(p.ws + WS_ROPE) + (pos * 64 + ((n & 127) >> 1)) * 2);
                const float x1 = a[0], x2 = a[1], y1 = a[2], y2 = a[3];
                a[0] = x1 * cs.x - x2 * cs.y; a[1] = x2 * cs.x + x1 * cs.y; a[2] = y1 * cs.z - y2 * cs.w; a[3] = y2 * cs.z + y1 * cs.w;
              }
            }
            uint2 u; u.x = pk2(a[0], a[1]); u.y = pk2(a[2], a[3]);
            *(uint2*)(ga.out + (size_t)m * ga.ldo + n) = u;
          } else {
            int b, tq; if (m < M_LAT) { b = m >> 12; tq = m & 4095; } else { b = (m - M_LAT) >> 8; tq = 4096 + ((m - M_LAT) & 255); }
            const int nn = n & 1023; const int h = nn >> 5, d = nn & 31;
            if (n < 1024) { a[0] *= 0.25503472251093067f; a[1] *= 0.25503472251093067f; a[2] *= 0.25503472251093067f; a[3] *= 0.25503472251093067f; }
            u16* dst = (u16*)(p.ws + WS_P) + (n < 1024 ? (size_t)0 : (size_t)35651584) + (((size_t)(b * 32 + h) * 4 + (d >> 3)) * TBN + tq) * 8 + (d & 7);
            uint2 u; u.x = pk2(a[0], a[1]); u.y = pk2(a[2], a[3]);
            *(uint2*)dst = u;
          }
        }
      }
    }
  }
}

DI void half_barrier(unsigned* ctr, unsigned target, int lane) {
  asm volatile("s_waitcnt lgkmcnt(0)" ::: "memory");
  if (lane == 0) (void)__hip_atomic_fetch_add(ctr, 1u, __ATOMIC_RELAXED, __HIP_MEMORY_SCOPE_WORKGROUP);
  while (__hip_atomic_load(ctr, __ATOMIC_RELAXED, __HIP_MEMORY_SCOPE_WORKGROUP) < target) __builtin_amdgcn_s_sleep(1);
  asm volatile("" ::: "memory");
}
DI void scan_phase(const Params& p, int jl, char* lds, int bid, int nblk) {
  const u16* P = (const u16*)(p.ws + WS_P); u16* O = (u16*)(p.ws + WS_O);
  const int tid = opaque_tid(), lane = tid & 63, w = tid >> 6, l15 = lane & 15, g = lane >> 4;
  const int DIR = w >> 2, wq = w & 3, ht = tid & 255;
  char* hb = lds + DIR * 40960;
  char* Qs = hb; char* Ks = hb + 16896; char* Vs = hb + 33792; char* Ps = hb + 38400;
  unsigned* hctr = (unsigned*)(lds + 81920) + DIR * 16;
  unsigned* octr = (unsigned*)(lds + 81920) + (DIR ^ 1) * 16;
  for (int item = bid; item < 256; item += nblk) {
    __syncthreads();
    if (tid < 32) ((unsigned*)(lds + 81920))[tid] = 0u;
    __syncthreads();
    unsigned nbar = 0;
    const int b = item >> 5, h = (item >> 3) & 3, vs = item & 7;
    const float lg2 = -__expf(p.ret_decay[jl * 8 + DIR * 4 + h]) * 1.4426950408889634f;
    const float gC = exp2f(32.f * lg2);
    float qdec[2], kdec[8], dmask[4];
#pragma unroll
    for (int ti = 0; ti < 2; ++ti) { const int tl = 16 * ti + l15; qdec[ti] = exp2f(lg2 * (float)(DIR ? 32 - tl : tl + 1)); }
#pragma unroll
    for (int e = 0; e < 8; ++e) { const int s = 8 * g + e; kdec[e] = exp2f(lg2 * (float)(DIR ? s : 31 - s)); }
    {
      const int t = 16 * (wq & 1) + l15;
#pragma unroll
      for (int r = 0; r < 4; ++r) { const int s = 16 * (wq >> 1) + 4 * g + r; const int d = DIR ? s - t : t - s; dmask[r] = d >= 0 ? exp2f(lg2 * (float)d) : 0.f; }
    }
    f32x4 S[16];
#pragma unroll
    for (int c = 0; c < 16; ++c) S[c] = (f32x4){0.f, 0.f, 0.f, 0.f};
    uint4 rq0, rq1, rq2, rq3, rk0, rk1, rk2, rk3, rv;
    auto row0 = [&](int step) -> int {
      if (step < 8) { const int cc = DIR ? 7 - step : step; return M_LAT + b * 256 + 32 * cc; }
      const int lc = DIR ? 127 - (step - 8) : step - 8; return b * 4096 + 32 * lc;
    };
#define SCAN_GLOAD(m0_) do { \
      const u16* src = P + (size_t)((m0_) + (ht >> 5)) * 4096 + h * 256 + (ht & 31) * 8; \
      rq0 = *(const uint4*)src; rk0 = *(const uint4*)(src + 1024); \
      rq1 = *(const uint4*)(src + 8 * 4096); rk1 = *(const uint4*)(src + 8 * 4096 + 1024); \
      rq2 = *(const uint4*)(src + 16 * 4096); rk2 = *(const uint4*)(src + 16 * 4096 + 1024); \
      rq3 = *(const uint4*)(src + 24 * 4096); rk3 = *(const uint4*)(src + 24 * 4096 + 1024); \
      rv = *(const uint4*)(P + (size_t)((m0_) + (ht >> 3)) * 4096 + 2048 + h * 512 + vs * 64 + (ht & 7) * 8); } while (0)
    SCAN_GLOAD(row0(0));
    for (int step = 0; step < 136; ++step) {
      const int m0 = row0(step);
      asm volatile("s_waitcnt vmcnt(0)" ::: "memory");
      half_barrier(hctr, 4u * (++nbar), lane);
      {
        const int so = (ht >> 5) * 528 + (ht & 31) * 16;
        *(uint4*)(Qs + so) = rq0; *(uint4*)(Ks + so) = rk0; *(uint4*)(Qs + so + 8 * 528) = rq1; *(uint4*)(Ks + so + 8 * 528) = rk1;
        *(uint4*)(Qs + so + 16 * 528) = rq2; *(uint4*)(Ks + so + 16 * 528) = rk2; *(uint4*)(Qs + so + 24 * 528) = rq3; *(uint4*)(Ks + so + 24 * 528) = rk3;
      }
      *(uint4*)(Vs + (ht >> 3) * 144 + (ht & 7) * 16) = rv;
      SCAN_GLOAD(row0(step + 1 < 136 ? step + 1 : step));
      const bool second = step < 8 ? step >= 4 : step >= 72;
      u16* const odst = O + (size_t)(m0 + l15) * 2048 + h * 512 + vs * 64 + 16 * wq + 4 * g;
      uint2 pv0 = make_uint2(0u, 0u), pv1 = pv0;
      if (second) {
        const int ko = step < 8 ? 7 - step : 143 - step;
        const unsigned need = 4u * (unsigned)(3 * (ko + 1) + 1);
        while (__hip_atomic_load(octr, __ATOMIC_RELAXED, __HIP_MEMORY_SCOPE_WORKGROUP) < need) __builtin_amdgcn_s_sleep(1);
        asm volatile("" ::: "memory");
        pv0 = *(const uint2*)odst; pv1 = *(const uint2*)(odst + (size_t)16 * 2048);
      }
      __builtin_amdgcn_sched_barrier(0);
      half_barrier(hctr, 4u * (++nbar), lane);
      {
        f32x4 sc = (f32x4){0.f, 0.f, 0.f, 0.f}, sc2 = sc;
        const char* kp = Ks + (16 * (wq >> 1) + l15) * 528 + g * 16; const char* qp = Qs + (16 * (wq & 1) + l15) * 528 + g * 16;
        bf16x8 kfr[8], qfr[8];
#pragma unroll
        for (int kk = 0; kk < 8; ++kk) { kfr[kk] = *(const bf16x8*)(kp + kk * 64); qfr[kk] = *(const bf16x8*)(qp + kk * 64); }
#pragma unroll
        for (int kk = 0; kk < 8; kk += 2) { sc = mfma16(kfr[kk], qfr[kk], sc); sc2 = mfma16(kfr[kk + 1], qfr[kk + 1], sc2); }
        sc[0] += sc2[0]; sc[1] += sc2[1]; sc[2] += sc2[2]; sc[3] += sc2[3];
        uint2 u; u.x = pk2(sc[0] * dmask[0], sc[1] * dmask[1]); u.y = pk2(sc[2] * dmask[2], sc[3] * dmask[3]);
        *(uint2*)(Ps + (16 * (wq & 1) + l15) * 80 + (16 * (wq >> 1) + 4 * g) * 2) = u;
      }
      half_barrier(hctr, 4u * (++nbar), lane);
      f32x4 oa[2], ob[2]; oa[0] = (f32x4){0.f, 0.f, 0.f, 0.f}; oa[1] = oa[0]; ob[0] = oa[0]; ob[1] = oa[0];
      {
        bf16x8 qf[2][2];
#define SCAN_LOADQ(dst_, pp_) _Pragma("unroll") for (int ti = 0; ti < 2; ++ti) { \
          const char* qb_ = Qs + (16 * ti + l15) * 528 + (32 * (pp_) + 4 * g) * 2; \
          const uint2 lo_ = *(const uint2*)qb_, hi_ = *(const uint2*)(qb_ + 32); \
          uint4 u_; u_.x = lo_.x; u_.y = lo_.y; u_.z = hi_.x; u_.w = hi_.y; dst_[ti] = __builtin_bit_cast(bf16x8, u_); }
        SCAN_LOADQ(qf[0], 0);
#pragma unroll
        for (int pp = 0; pp < 8; ++pp) {
          if (pp + 1 < 8) { SCAN_LOADQ(qf[(pp + 1) & 1], pp + 1); }
          float sv[8];
#pragma unroll
          for (int e = 0; e < 4; ++e) { sv[e] = S[2 * pp][e]; sv[4 + e] = S[2 * pp + 1][e]; }
          const bf16x8 af = pack8(sv);
          if (pp & 1) { ob[0] = mfma16(af, qf[pp & 1][0], ob[0]); ob[1] = mfma16(af, qf[pp & 1][1], ob[1]); }
          else { oa[0] = mfma16(af, qf[pp & 1][0], oa[0]); oa[1] = mfma16(af, qf[pp & 1][1], oa[1]); }
          __builtin_amdgcn_sched_barrier(0);
        }
#pragma unroll
        for (int ti = 0; ti < 2; ++ti) { oa[ti][0] += ob[ti][0]; oa[ti][1] += ob[ti][1]; oa[ti][2] += ob[ti][2]; oa[ti][3] += ob[ti][3]; }
      }
#pragma unroll
      for (int ti = 0; ti < 2; ++ti) { oa[ti][0] *= qdec[ti]; oa[ti][1] *= qdec[ti]; oa[ti][2] *= qdec[ti]; oa[ti][3] *= qdec[ti]; }
      const int q4 = l15 >> 2, p4 = l15 & 3;
      const char* vb = Vs + (8 * g + q4) * 144 + (16 * wq + 4 * p4) * 2;
      const bf16x8 vf = cat8(tr_read(vb), tr_read(vb + 4 * 144));
#pragma unroll
      for (int ti = 0; ti < 2; ++ti) oa[ti] = mfma16(vf, *(const bf16x8*)(Ps + (16 * ti + l15) * 80 + g * 16), oa[ti]);
#pragma unroll
      for (int ti = 0; ti < 2; ++ti) {
        u16* dst = odst + (size_t)(16 * ti) * 2048;
        const uint2 pv = ti ? pv1 : pv0;
        const float o0 = oa[ti][0] + bf2f((u16)(pv.x & 0xffff)), o1 = oa[ti][1] + bf2f((u16)(pv.x >> 16));
        const float o2 = oa[ti][2] + bf2f((u16)(pv.y & 0xffff)), o3 = oa[ti][3] + bf2f((u16)(pv.y >> 16));
        uint2 u; u.x = pk2(o0, o1); u.y = pk2(o2, o3);
        *(uint2*)dst = u;
      }
      {
        float sv[8];
#pragma unroll
        for (int e = 0; e < 8; ++e) sv[e] = bf2f((u16)vf[e]) * kdec[e];
        const bf16x8 vsf = pack8(sv);
        const char* kb = Ks + (8 * g + q4) * 528 + (4 * p4) * 2;
        bf16x8 kf[2][4];
#define SCAN_LOADK(dst_, cb_) _Pragma("unroll") for (int c4 = 0; c4 < 4; ++c4) dst_[c4] = cat8(tr_read(kb + ((cb_) * 4 + c4) * 32), tr_read(kb + ((cb_) * 4 + c4) * 32 + 4 * 528))
        SCAN_LOADK(kf[0], 0);
#pragma unroll
        for (int cb = 0; cb < 4; ++cb) {
          if (cb + 1 < 4) { SCAN_LOADK(kf[(cb + 1) & 1], cb + 1); }
#pragma unroll
          for (int c4 = 0; c4 < 4; ++c4) {
            const int c = cb * 4 + c4;
            f32x4 sc = S[c]; sc[0] *= gC; sc[1] *= gC; sc[2] *= gC; sc[3] *= gC;
            S[c] = mfma16(kf[cb & 1][c4], vsf, sc);
          }
          __builtin_amdgcn_sched_barrier(0);
        }
      }
    }
  }
}

DI void finish_phase(const Params& p, int bid, int nblk) {
  u16* O = (u16*)(p.ws + WS_O); const u16* G = (const u16*)(p.ws + WS_P);
  const int tid_ = opaque_tid(); const int lane = tid_ & 63, w = tid_ >> 6;
  for (int m = bid * NWV + w; m < M_ALL; m += nblk * NWV) {
    const size_t base = (size_t)m * 2048 + lane * 8;
    uint4 ov[4], gv[4];
#pragma unroll
    for (int h = 0; h < 4; ++h) { ov[h] = *(const uint4*)(O + base + h * 512); gv[h] = *(const uint4*)(G + base + h * 512); }
#pragma unroll
    for (int h = 0; h < 4; ++h) {
      float o[8], gg[8];
      const unsigned ou[4] = {ov[h].x, ov[h].y, ov[h].z, ov[h].w}, gu[4] = {gv[h].x, gv[h].y, gv[h].z, gv[h].w};
#pragma unroll
      for (int e = 0; e < 4; ++e) { o[2 * e] = bf2f((u16)(ou[e] & 0xffff)); o[2 * e + 1] = bf2f((u16)(ou[e] >> 16)); gg[2 * e] = bf2f((u16)(gu[e] & 0xffff)); gg[2 * e + 1] = bf2f((u16)(gu[e] >> 16)); }
      float s = 0.f;
#pragma unroll
      for (int e = 0; e < 8; ++e) s += o[e];
#pragma unroll
      for (int x = 32; x >= 1; x >>= 1) s += __shfl_xor(s, x);
      const float mu = s * (1.f / 512.f);
      float q = 0.f;
#pragma unroll
      for (int e = 0; e < 8; ++e) { o[e] -= mu; q += o[e] * o[e]; }
#pragma unroll
      for (int x = 32; x >= 1; x >>= 1) q += __shfl_xor(q, x);
      const float rstd = rsqrtf(q * (1.f / 512.f) + 1e-5f);
      float r[8];
#pragma unroll
      for (int e = 0; e < 8; ++e) r[e] = o[e] * rstd * gg[e];
      uint4 u; u.x = pk2(r[0], r[1]); u.y = pk2(r[2], r[3]); u.z = pk2(r[4], r[5]); u.w = pk2(r[6], r[7]);
      *(uint4*)(O + base + h * 512) = u;
    }
  }
}

struct KV4 { bf16x8 ka, kb, v0, v1; };
DI KV4 nat_load(const u16* Kh, const u16* Vt, size_t bh, int tb, int l15, int g) {
  KV4 r;
  const u16* kp = Kh + ((bh * 4 + g) * TBN + tb + l15) * 8;
  r.ka = *(const bf16x8*)kp; r.kb = *(const bf16x8*)(kp + 128);
  const u16* vp = Vt + ((bh * (TBN / 4) + (tb >> 2) + g) * 32 + l15) * 4;
  const uint2 a0 = *(const uint2*)vp, a1 = *(const uint2*)(vp + 512), b0 = *(const uint2*)(vp + 64), b1 = *(const uint2*)(vp + 512 + 64);
  uint4 u; u.x = a0.x; u.y = a0.y; u.z = a1.x; u.w = a1.y; r.v0 = __builtin_bit_cast(bf16x8, u);
  u.x = b0.x; u.y = b0.y; u.z = b1.x; u.w = b1.y; r.v1 = __builtin_bit_cast(bf16x8, u);
  return r;
}
template <bool FIRST, bool BIAS>
DI void nat_compute2(const KV4 ka_, const KV4 kb_, bf16x8 qf, const float* browA, const float* browB, const int (&bidx)[8], unsigned vmask,
                     float& mref, float& lsum, f32x4& oa0, f32x4& oa1, f32x4& ob0, f32x4& ob1) {
  const f32x4 z = (f32x4){0.f, 0.f, 0.f, 0.f};
  const f32x4 sa0 = mfma16(ka_.ka, qf, z), sb0 = mfma16(ka_.kb, qf, z), sa1 = mfma16(kb_.ka, qf, z), sb1 = mfma16(kb_.kb, qf, z);
  float s[16];
#pragma unroll
  for (int e = 0; e < 4; ++e) { s[e] = sa0[e]; s[4 + e] = sb0[e]; s[8 + e] = sa1[e]; s[12 + e] = sb1[e]; }
  if (BIAS) {
    float bv[16];
#pragma unroll
    for (int e = 0; e < 8; ++e) { bv[e] = browA[bidx[e]]; bv[8 + e] = browB[bidx[e]]; }
#pragma unroll
    for (int e = 0; e < 16; ++e) s[e] = ((vmask >> (e & 7)) & 1u) ? s[e] + bv[e] : -1e30f;
  }
  if (FIRST) {
    float tm = s[0];
#pragma unroll
    for (int e = 1; e < 16; ++e) tm = fmaxf(tm, s[e]);
    tm = fmaxf(tm, __shfl_xor(tm, 16)); tm = fmaxf(tm, __shfl_xor(tm, 32));
    mref = tm;
  }
  float ps = 0.f;
#pragma unroll
  for (int e = 0; e < 16; ++e) { s[e] = __builtin_amdgcn_exp2f(fminf(s[e] - mref, 100.f)); ps += s[e]; }
  lsum += ps;
  const bf16x8 pfA = pack8(s), pfB = pack8(s + 8);
  oa0 = mfma16(ka_.v0, pfA, oa0); oa1 = mfma16(ka_.v1, pfA, oa1);
  ob0 = mfma16(kb_.v0, pfB, ob0); ob1 = mfma16(kb_.v1, pfB, ob1);
}

DI void nat_phase(const Params& p, int jl, bool ctx_out, char* lds, int bid, int nblk) {
  const u16* Qh = (const u16*)(p.ws + WS_P); const u16* Kh = Qh + 35651584; const u16* Vt = Kh + 35651584;
  u16* O = (u16*)(p.ws + WS_O);
  float* rpall = (float*)lds;
  const int tid = opaque_tid(), lane = tid & 63, w = tid >> 6, l15 = lane & 15, g = lane >> 4;
  const int w4 = w & 3;
  __syncthreads();
  for (int i = tid; i < 32 * 465; i += NTHR) rpall[i] = p.nat_rpb[(size_t)jl * 32 * 465 + i] * 1.4426950408889634f;
  __syncthreads();
  const int nitems = 8192 + (ctx_out ? 512 : 0);
  for (int item = bid; item < nitems; item += nblk) {
    int b, h, r = 0, qg = 0; const bool isctx = item >= 8192;
    if (!isctx) { const int pair = (item >> 8) * 8 + (item & 7); r = ((item >> 3) & 31) * 2 + (w >> 2); b = pair >> 5; h = pair & 31; }
    else { const int it = item - 8192; b = it >> 6; h = (it >> 1) & 31; qg = (it & 1) * 8 + w; }
    const float* rp = rpall + h * 465;
    const size_t bh = (size_t)(b * 32 + h);
    const int tq = isctx ? 4096 + 16 * qg + l15 : r * 64 + 16 * w4 + l15;
    const bf16x8 qf = *(const bf16x8*)(Qh + ((bh * 4 + g) * TBN + tq) * 8);
    float mrun = -1e30f, lsum = 0.f; f32x4 o0 = (f32x4){0.f, 0.f, 0.f, 0.f}, o1 = o0;
    const int rs = min(max(r - 4, 0), 56), co = min(max(16 * w4 - 8, 0), 32), qc = 16 * w4 + l15, cs = min(max(qc - 8, 0), 48);
    int bidx[8]; unsigned vmask = 0;
#pragma unroll
    for (int e = 0; e < 8; ++e) {
      const int kc = co + 4 * g + (e & 3) + (e >> 2) * 16; const bool valid = kc >= cs && kc < cs + 16;
      bidx[e] = min(max(kc - qc + 15, 0), 30); vmask |= valid ? (1u << e) : 0u;
    }
#define NAT_TB(t_) ((t_) < 8 ? (rs + (t_)) * 64 + co : 4096 + 32 * ((t_) - 8))
    f32x4 p0 = (f32x4){0.f, 0.f, 0.f, 0.f}, p1 = p0;
#define NAT_BROW(t_) (rp + (rs + (t_) - r + 7) * 31)
#define NAT_RUN(T0_) do { \
      KV4 kq_[2][2]; \
      kq_[0][0] = nat_load(Kh, Vt, bh, NAT_TB(T0_), l15, g); kq_[0][1] = nat_load(Kh, Vt, bh, NAT_TB((T0_) + 1), l15, g); \
      _Pragma("unroll") for (int t = (T0_); t < 16; t += 2) { \
        const int pb_ = ((t - (T0_)) >> 1) & 1; \
        if (t + 2 < 16) { kq_[pb_ ^ 1][0] = nat_load(Kh, Vt, bh, NAT_TB(t + 2), l15, g); kq_[pb_ ^ 1][1] = nat_load(Kh, Vt, bh, NAT_TB(t + 3), l15, g); } \
        __builtin_amdgcn_sched_barrier(0); \
        if (t == (T0_)) { if (t < 8) nat_compute2<true, true>(kq_[pb_][0], kq_[pb_][1], qf, NAT_BROW(t), NAT_BROW(t + 1), bidx, vmask, mrun, lsum, o0, o1, p0, p1); \
                          else nat_compute2<true, false>(kq_[pb_][0], kq_[pb_][1], qf, nullptr, nullptr, bidx, vmask, mrun, lsum, o0, o1, p0, p1); } \
        else { if (t < 8) nat_compute2<false, true>(kq_[pb_][0], kq_[pb_][1], qf, NAT_BROW(t), NAT_BROW(t + 1), bidx, vmask, mrun, lsum, o0, o1, p0, p1); \
               else nat_compute2<false, false>(kq_[pb_][0], kq_[pb_][1], qf, nullptr, nullptr, bidx, vmask, mrun, lsum, o0, o1, p0, p1); } \
      } } while (0)
    if (!isctx) NAT_RUN(0); else NAT_RUN(8);
    o0[0] += p0[0]; o0[1] += p0[1]; o0[2] += p0[2]; o0[3] += p0[3]; o1[0] += p1[0]; o1[1] += p1[1]; o1[2] += p1[2]; o1[3] += p1[3];
    lsum += __shfl_xor(lsum, 16); lsum += __shfl_xor(lsum, 32);
    const float inv = 1.f / lsum;
    const int m = isctx ? M_LAT + b * 256 + 16 * qg + l15 : b * 4096 + tq;
    u16* dst = O + (size_t)m * 1024 + h * 32 + 4 * g;
    uint2 u; u.x = pk2(o0[0] * inv, o0[1] * inv); u.y = pk2(o0[2] * inv, o0[3] * inv); *(uint2*)dst = u;
    u.x = pk2(o1[0] * inv, o1[1] * inv); u.y = pk2(o1[2] * inv, o1[3] * inv); *(uint2*)(dst + 16) = u;
  }
}


#define XB_TMO      128
#define XB_XCNT(j)  (256  + 64 * (j))
#define XB_XSUB(j)  (1280 + 64 * (j))
#define XB_XGEN(j)  (2304 + 64 * (j))
#define XB_TOP      3328
#define XB_TOPGEN   3392
#define XCD_BAR_WORDS 3456
#define XB_SPIN_CAP (1u << 22)
#define LAS __attribute__((address_space(3)))
DI unsigned xb_ld(unsigned* p) { return __hip_atomic_load(p, __ATOMIC_RELAXED, __HIP_MEMORY_SCOPE_AGENT); }
DI unsigned xb_add(unsigned* p, unsigned v) { return __hip_atomic_fetch_add(p, v, __ATOMIC_RELAXED, __HIP_MEMORY_SCOPE_AGENT); }
DI unsigned xb_xcc_id() { return (unsigned)__builtin_amdgcn_s_getreg((3 << 11) | 20) & 0xFu; }
#define XB_SPIN(cond, bar) do { unsigned _sp = 0; while (cond) { __builtin_amdgcn_s_sleep(1); \
    if ((++_sp & 255u) == 0u) { if (xb_ld(&(bar)[XB_TMO])) break; if (_sp > XB_SPIN_CAP) { atomicAdd(&(bar)[XB_TMO], 1u); break; } } } } while (0)
struct XcdBarrier { unsigned* bar; unsigned x; volatile LAS unsigned* st; };
DI XcdBarrier xcd_barrier_post(unsigned* bar, volatile LAS unsigned* st) {
  XcdBarrier b; b.bar = bar; b.x = xb_xcc_id(); b.st = st;
  if (threadIdx.x == 0) (void)xb_add(&bar[XB_XCNT(b.x)], 1u);
  return b;
}
DI void xcd_barrier_complete(unsigned* bar, unsigned x, unsigned& nloc, unsigned& nx) {
  const unsigned G = gridDim.x * gridDim.y * gridDim.z;
  unsigned sum, cnt, mine, sp = 0u;
  for (;;) {
    sum = 0u; cnt = 0u; mine = 0u;
#pragma unroll
    for (unsigned j = 0; j < 16; ++j) { const unsigned c = xb_ld(&bar[XB_XCNT(j)]); sum += c; cnt += (c > 0u) ? 1u : 0u; mine = (j == x) ? c : mine; }
    if (sum == G) break;
    __builtin_amdgcn_s_sleep(1);
    if ((++sp & 255u) == 0u) { if (xb_ld(&bar[XB_TMO])) break; if (sp > XB_SPIN_CAP) { atomicAdd(&bar[XB_TMO], 1u); break; } }
  }
  nloc = mine > 0u ? mine : 1u; nx = cnt > 0u ? cnt : 1u;
}
DI void xcd_barrier(const XcdBarrier& b) {
  asm volatile("s_waitcnt vmcnt(0)" ::: "memory");
  __syncthreads();
  if (threadIdx.x == 0) {
    unsigned* bar = b.bar;
    __builtin_amdgcn_s_waitcnt(0);
    unsigned nloc = b.st[0], nx = b.st[1];
    if (nloc == 0u) { xcd_barrier_complete(bar, b.x, nloc, nx); b.st[0] = nloc; b.st[1] = nx; }
    const unsigned old = xb_add(&bar[XB_XSUB(b.x)], 1u);
    const unsigned gen = old / nloc;
    if (old + 1u == (gen + 1u) * nloc) {
      __builtin_amdgcn_fence(__ATOMIC_RELEASE, "agent");
      asm volatile("s_waitcnt vmcnt(0)" ::: "memory");
      const unsigned og = xb_add(&bar[XB_TOP], 1u);
      const unsigned tg = og / nx;
      if (og + 1u == (tg + 1u) * nx) xb_add(&bar[XB_TOPGEN], 1u);
      else XB_SPIN(xb_ld(&bar[XB_TOPGEN]) == tg, bar);
      __builtin_amdgcn_fence(__ATOMIC_ACQUIRE, "agent");
      xb_add(&bar[XB_XGEN(b.x)], 1u);
      asm volatile("s_waitcnt vmcnt(0)" ::: "memory");
    } else {
      XB_SPIN(xb_ld(&bar[XB_XGEN(b.x)]) == gen, bar);
      __builtin_amdgcn_fence(__ATOMIC_ACQUIRE, "agent");
      asm volatile("s_waitcnt vmcnt(0)" ::: "memory");
    }
  }
  __syncthreads();
}

__global__ void __launch_bounds__(512, 2) mega(Params p) {
  extern __shared__ __attribute__((aligned(16))) char lds[];
  cg::grid_group grid = cg::this_grid();
  const int bid = blockIdx.x, nblk = gridDim.x;
  __shared__ __attribute__((aligned(16))) unsigned xb_st[4];
  if (threadIdx.x < 4) xb_st[threadIdx.x] = 0u;
  __syncthreads();
  const XcdBarrier xb = xcd_barrier_post((unsigned*)(p.ws + WS_END), (volatile LAS unsigned*)xb_st);
  const float* mod = (const float*)(p.ws + WS_MOD);
  u16* HM = (u16*)(p.ws + WS_HM); u16* PB = (u16*)(p.ws + WS_P); u16* OB = (u16*)(p.ws + WS_O);
  u16* WA = (u16*)(p.ws + WS_WA); u16* WAO = (u16*)(p.ws + WS_WAO);

  mod_phase(p, lds, bid, nblk);
  conv_WA(p, 0, lds, bid, nblk);
  grid.sync();
  ln_phase(p, false, nullptr, nullptr, mod, 0, true, M_ALL, bid, nblk);
  xcd_barrier(xb);
  for (int i = 0; i < 4; ++i) {
    const bool last = i == 3; const int jl = i >> 1; const int Mr = last ? M_LAT : M_ALL;
    const float* modl = mod + (size_t)i * 9 * 6144;
    GArgs go{};
    if ((i & 1) == 0) {
      { GArgs ga{}; ga.A = HM; ga.lda = 1024; ga.Bt = WA; ga.ldb = 1024; ga.M = M_LAT; ga.N = 4096; ga.K = 1024; ga.out = PB; ga.ldo = 4096;
        gemm_phase<EP_RET_QKV, 4>(p, ga, lds, bid, nblk);
        ga.m0 = M_LAT; ga.M = M_ALL - M_LAT; gemm_phase<EP_RET_QKV, 2>(p, ga, lds, bid, nblk); }
      xcd_barrier(xb);
      scan_phase(p, jl, lds, bid, nblk);
      xcd_barrier(xb);
      if (DUP_M) { scan_phase(p, jl, lds, bid, nblk); xcd_barrier(xb); }
      { GArgs ga{}; ga.A = HM; ga.lda = 1024; ga.Bt = WA + (size_t)4096 * 1024; ga.ldb = 1024; ga.M = M_LAT; ga.N = 2048; ga.K = 1024; ga.out = PB; ga.ldo = 2048;
        gemm_phase<EP_RET_G, 4>(p, ga, lds, bid, nblk);
        ga.m0 = M_LAT; ga.M = M_ALL - M_LAT; gemm_phase<EP_RET_G, 2>(p, ga, lds, bid, nblk); }
      xcd_barrier(xb);
      finish_phase(p, bid, nblk);
      xcd_barrier(xb);
      go.A = OB; go.lda = 2048; go.Bt = WAO; go.ldb = 2048; go.K = 2048;
    } else {
      { GArgs ga{}; ga.A = HM; ga.lda = 1024; ga.Bt = WA; ga.ldb = 1024; ga.M = M_LAT; ga.N = 3072; ga.K = 1024;
        gemm_phase<EP_NAT, 4>(p, ga, lds, bid, nblk);
        ga.m0 = M_LAT; ga.M = M_ALL - M_LAT; gemm_phase<EP_NAT, 2>(p, ga, lds, bid, nblk); }
      xcd_barrier(xb);
      nat_phase(p, jl, !last, lds, bid, nblk);
      xcd_barrier(xb);
      if (DUP_M) { nat_phase(p, jl, !last, lds, bid, nblk); xcd_barrier(xb); }
      go.A = OB; go.lda = 1024; go.Bt = WAO; go.ldb = 1024; go.K = 1024;
    }
    go.M = Mr; go.N = 1024; go.gate = modl + 2048;
    go.M = M_LAT; gemm_phase<EP_RESID, 4>(p, go, lds, bid, nblk);
    if (!last) { go.m0 = M_LAT; go.M = M_ALL - M_LAT; go.out = PB; gemm_phase<EP_RESID_SK, 2>(p, go, lds, bid, nblk); }
    xcd_barrier(xb);
    conv_WB(p, i, lds, bid, nblk);
    ln_phase(p, true, p.ln_g + (size_t)(i * 2) * 1024, p.ln_b + (size_t)(i * 2) * 1024, modl, 3072, true, Mr, bid, nblk, (const float*)PB);
    xcd_barrier(xb);
    { GArgs ga{}; ga.A = HM; ga.lda = 1024; ga.Bt = OB; ga.ldb = 1024; ga.M = M_LAT; ga.N = 4096; ga.K = 1024; ga.out = PB; ga.ldo = 4096;
      gemm_phase<EP_RELU2, 4>(p, ga, lds, bid, nblk);
      if (!last) { ga.m0 = M_LAT; ga.M = M_ALL - M_LAT; gemm_phase<EP_RELU2, 2>(p, ga, lds, bid, nblk); } }
    xcd_barrier(xb);
    { GArgs ga{}; ga.A = PB; ga.lda = 4096; ga.Bt = OB + (size_t)4096 * 1024; ga.ldb = 4096; ga.M = Mr; ga.N = 1024; ga.K = 4096; ga.gate = modl + 5120;
      ga.M = M_LAT; gemm_phase<EP_RESID, 4>(p, ga, lds, bid, nblk);
      if (!last) { ga.m0 = M_LAT; ga.M = M_ALL - M_LAT; ga.out = (u16*)(p.ws + WS_O + 16 * MiB); gemm_phase<EP_RESID_SK, 2>(p, ga, lds, bid, nblk); } }
    xcd_barrier(xb);
    if (!last) conv_WA(p, i + 1, lds, bid, nblk);
    ln_phase(p, true, p.ln_g + (size_t)(i * 2 + 1) * 1024, p.ln_b + (size_t)(i * 2 + 1) * 1024, modl + 9 * 6144, 0, !last, Mr, bid, nblk, (const float*)(p.ws + WS_O + 16 * MiB));
    if (!last) xcd_barrier(xb);
  }
}

extern "C" void kernel_launch(void* const* d_in, const int* in_sizes, int n_in, void* d_out, int out_size, void* d_ws, size_t ws_size, hipStream_t stream) {
  static int grid_blocks = 0;
  if (!grid_blocks) {
    int dev = 0, cus = 0, per_cu = 0;
    hipGetDevice(&dev);
    hipDeviceGetAttribute(&cus, hipDeviceAttributeMultiprocessorCount, dev);
    hipFuncSetAttribute((const void*)mega, hipFuncAttributeMaxDynamicSharedMemorySize, LDS_BYTES);
    hipOccupancyMaxActiveBlocksPerMultiprocessor(&per_cu, (const void*)mega, NTHR, LDS_BYTES);
    if (per_cu > 1) per_cu = 1;
    if (per_cu < 1) per_cu = 1;
    grid_blocks = cus * per_cu;
    if (ws_size < WS_END + 65536) fprintf(stderr, "kernel_launch: workspace too small: %zu < %zu\n", ws_size, (size_t)WS_END);
  }
  Params p{};
  p.x = (const float*)d_in[0]; p.c = (const float*)d_in[1]; p.ctx = (const float*)d_in[2]; p.c_ctx = (const float*)d_in[3];
  p.ada_w = (const float*)d_in[4]; p.ada_b = (const float*)d_in[5]; p.ret_w_in = (const float*)d_in[6]; p.ret_w_o = (const float*)d_in[7];
  p.ret_decay = (const float*)d_in[8]; p.nat_w_in = (const float*)d_in[9]; p.nat_w_o = (const float*)d_in[10]; p.nat_rpb = (const float*)d_in[11];
  p.mlp_w1 = (const float*)d_in[12]; p.mlp_w2 = (const float*)d_in[13]; p.ln_g = (const float*)d_in[14]; p.ln_b = (const float*)d_in[15];
  p.out = (float*)d_out; p.ws = (char*)d_ws;
  (void)hipMemsetAsync((char*)d_ws + WS_END, 0, XCD_BAR_WORDS * sizeof(unsigned), stream);
  void* args[] = {&p};
  hipError_t e = hipLaunchCooperativeKernel((const void*)mega, dim3(grid_blocks), dim3(NTHR), args, LDS_BYTES, stream);
  if (e != hipSuccess) fprintf(stderr, "cooperative launch failed: %s (grid %d)\n", hipGetErrorString(e), grid_blocks);
}
```
